# Optimizing an MI355X kernel written in HIP

```python
import math
import jax, jax.numpy as jnp
from jax import lax
import numpy as np

D_MODEL = 2048
BATCH = 1
SEQ = 16384
DEPTH = 1
DEC_BATCH = 32
DEC_SEQ = 4
PAST_LEN = 16384
PAGE_SIZE = 128

DK_A = 128
DV_A = 128
H_A = D_MODEL // 256
W_AK = H_A * DK_A
W_AV = H_A * DV_A
HGRN_CHUNK = 64
PATTERNS = ((128, 1), (512, 4), (2048, 16))
N_GROUPS = 3
HPG = D_MODEL // 512
H_B = N_GROUPS * HPG
HEAD_DIM = 128
W_B = H_B * HEAD_DIM
W_B_OUT = HPG * HEAD_DIM
D_FF = 256 * ((8 * D_MODEL // 3 + 255) // 256)
CONV_W = 3
IN_SIZES = (W_AK, W_AK, W_AV, W_AV, W_B, W_B, W_B, D_MODEL, D_MODEL)
N_IN = sum(IN_SIZES)
EPS = 1e-6

kernel_name = 'hgrn2_dilated_swa_hybrid_step'


def rmsnorm(x, w):
    xf = x.astype(jnp.float32)
    xf = xf * lax.rsqrt(jnp.mean(xf * xf, axis=-1, keepdims=True) + EPS)
    return (xf * w.astype(jnp.float32)).astype(x.dtype)


def alibi_slopes():
    s = 2.0 ** (-8.0 * np.arange(1, H_B + 1, dtype=np.float32) / H_B)
    return jnp.asarray(s, jnp.float32).reshape(N_GROUPS, HPG)


def split_in(z):
    offs = [int(o) for o in np.cumsum(IN_SIZES)[:-1]]
    return jnp.split(z, offs, axis=-1)


def hgrn2_scan(q, k, log_f, v, S0):
    B, T, H, DK = q.shape
    DV = v.shape[-1]
    C = math.gcd(T, HGRN_CHUNK)
    N = T // C

    def chunks(a):
        return a.astype(jnp.float32).reshape(B, N, C, H, a.shape[-1]).transpose(1, 0, 3, 2, 4)

    qc, kc, gc, vc = chunks(q), chunks(k), chunks(log_f), chunks(v)
    causal = jnp.tril(jnp.ones((C, C), dtype=bool))

    def step(S, inp):
        qi, ki, gi, vi = inp
        cum = jnp.cumsum(gi, axis=2)
        inter = jnp.einsum('bhtk,bhkv->bhtv', qi * jnp.exp(cum), S)
        rel = cum[:, :, :, None, :] - cum[:, :, None, :, :]
        decay = jnp.exp(jnp.where(causal[:, :, None], rel, -jnp.inf))
        scores = jnp.einsum('bhtk,bhsk,bhtsk->bhts', qi, ki, decay)
        intra = jnp.einsum('bhts,bhsv->bhtv', scores, vi)
        total = cum[:, :, -1:, :]
        kdec = ki * jnp.exp(total - cum)
        S_new = jnp.exp(total[:, :, 0, :])[..., None] * S + jnp.einsum('bhsk,bhsv->bhkv', kdec, vi)
        return S_new, inter + intra

    S_fin, o = lax.scan(step, S0.astype(jnp.float32), (qc, kc, gc, vc))
    o = o.transpose(1, 0, 3, 2, 4).reshape(B, T, H, DV)
    return o, S_fin


def softmax_stats(s):
    m = jnp.max(s, axis=-1, keepdims=True)
    p = jnp.exp(s - m)
    den = jnp.sum(p, axis=-1, keepdims=True)
    return p / den, (m + jnp.log(den))[..., 0]


def dilated_attn_prompt(q, k, v, slopes, window, dil):
    B, T, H, Dh = q.shape
    nb = window // dil
    blk = nb
    unit = dil * blk
    Tp = -(-T // unit) * unit
    M = Tp // dil
    NB = M // blk

    def res_blocks(a):
        a = jnp.pad(a, ((0, 0), (0, Tp - T), (0, 0), (0, 0)))
        a = a.reshape(B, M, dil, H, Dh).transpose(0, 2, 3, 1, 4)
        return a.reshape(B, dil, H, NB, blk, Dh)

    def with_prev(a):
        prev = jnp.concatenate([jnp.zeros_like(a[:, :, :, :1]), a[:, :, :, :-1]], axis=3)
        return jnp.concatenate([prev, a], axis=4)

    qb = res_blocks(q)
    kk = with_prev(res_blocks(k))
    vv = with_prev(res_blocks(v))
    s = jnp.einsum('brhnqd,brhnkd->brhnqk', qb, kk).astype(jnp.float32) * (Dh ** -0.5)
    i = jnp.arange(blk)[:, None]
    j = jnp.arange(2 * blk)[None, :]
    delta = blk + i - j
    key_idx = jnp.arange(NB)[:, None, None] * blk + j[None] - blk
    valid = ((delta >= 0) & (delta <= nb))[None] & (key_idx >= 0)
    bias = -slopes[:, None, None] * (delta * dil).astype(jnp.float32)[None]
    s = jnp.where(valid, s + bias[:, None], -jnp.inf)
    p, lse = softmax_stats(s)
    o = jnp.einsum('brhnqk,brhnkd->brhnqd', p, vv.astype(jnp.float32))
    o = o.reshape(B, dil, H, M, Dh).transpose(0, 3, 1, 2, 4).reshape(B, Tp, H, Dh)[:, :T]
    lse = lse.reshape(B, dil, H, M).transpose(0, 3, 1, 2).reshape(B, Tp, H)[:, :T]
    return o, lse


def dilated_attn_sample(q, k_new, v_new, kv_buf, slopes, window, dil):
    B, S, H, Dh = q.shape
    L = kv_buf.shape[1]
    nk = window // dil + 1
    k_all = jnp.concatenate([kv_buf[:, :, 0], k_new], axis=1)
    v_all = jnp.concatenate([kv_buf[:, :, 1], v_new], axis=1)
    i = jnp.arange(S)[:, None]
    j = jnp.arange(nk)[None, :]
    idx = L + i - j * dil
    valid = idx >= 0
    idx_c = jnp.maximum(idx, 0)
    kg = k_all[:, idx_c]
    vg = v_all[:, idx_c]
    s = jnp.einsum('bshd,bsjhd->bshj', q, kg).astype(jnp.float32) * (Dh ** -0.5)
    bias = -slopes[:, None] * (j[0] * dil).astype(jnp.float32)[None]
    s = jnp.where(valid[None, :, None, :], s + bias, -jnp.inf)
    p, lse = softmax_stats(s)
    o = jnp.einsum('bshj,bsjhd->bshd', p, vg.astype(jnp.float32))
    return o, lse


def conv_ffn(h, buf, w_up, conv_w, conv_b, w_down):
    T = h.shape[1]
    u = h @ w_up
    up = jnp.concatenate([buf.astype(u.dtype), u], axis=1)
    c = conv_b
    for j in range(CONV_W):
        c = c + conv_w[j] * up[:, j:j + T]
    g, a = jnp.split(c, 2, axis=-1)
    out = (jax.nn.silu(g) * a) @ w_down
    return out, up[:, -(CONV_W - 1):]


def trunk_layer(x, S0, kv_bufs, conv_buf, norm_mix_w, w_in, lb, hgrn_norm_w, w_proj_a, w_proj_b,
                w_out, norm_ffn_w, w_up, conv_w, conv_b, w_down, slopes):
    B, T, _ = x.shape
    h = rmsnorm(x, norm_mix_w)
    zq, zf, zi, zg, aq, ak, av, gate_a, gate_b = split_in(h @ w_in)
    f = lb + (1.0 - lb) * jax.nn.sigmoid(zf.astype(jnp.float32))
    q_a = jax.nn.silu(zq).reshape(B, T, H_A, DK_A)
    k_a = (1.0 - f).reshape(B, T, H_A, DK_A)
    logf_a = jnp.log(f).reshape(B, T, H_A, DK_A)
    v_a = zi.reshape(B, T, H_A, DV_A)
    o_a, S_new = hgrn2_scan(q_a, k_a, logf_a, v_a, S0)
    o_a = rmsnorm(o_a, hgrn_norm_w.reshape(H_A, DV_A)) * jax.nn.silu(zg.reshape(B, T, H_A, DV_A).astype(jnp.float32))
    y_a = o_a.astype(x.dtype).reshape(B, T, W_AV) @ w_proj_a
    q_b = aq.reshape(B, T, N_GROUPS, HPG, HEAD_DIM)
    k_b = ak.reshape(B, T, N_GROUPS, HPG, HEAD_DIM)
    v_b = av.reshape(B, T, N_GROUPS, HPG, HEAD_DIM)
    outs, lses, new_kv = [], [], []
    for g, (win, dil) in enumerate(PATTERNS):
        qg, kg, vg = q_b[:, :, g], k_b[:, :, g], v_b[:, :, g]
        kv_new = jnp.stack([kg, vg], axis=2)
        if kv_bufs is None:
            o, lse = dilated_attn_prompt(qg, kg, vg, slopes[g], win, dil)
            kv_state = kv_new[:, -min(win, T):]
        else:
            o, lse = dilated_attn_sample(qg, kg, vg, kv_bufs[g], slopes[g], win, dil)
            L = kv_bufs[g].shape[1]
            kv_state = jnp.concatenate([kv_bufs[g].astype(kv_new.dtype), kv_new], axis=1)[:, -L:]
        outs.append(o)
        lses.append(lse)
        new_kv.append(kv_state)
    wts = jax.nn.softmax(jnp.stack(lses, axis=0), axis=0)
    o_b = jnp.sum(wts[..., None] * jnp.stack(outs, axis=0), axis=0).astype(x.dtype)
    y_b = o_b.reshape(B, T, W_B_OUT) @ w_proj_b
    mix = jax.nn.sigmoid(gate_a) * y_a + jax.nn.sigmoid(gate_b) * y_b
    x = x + mix @ w_out
    ffn, conv_state = conv_ffn(rmsnorm(x, norm_ffn_w), conv_buf, w_up, conv_w, conv_b, w_down)
    x = x + ffn
    return x, S_new.astype(x.dtype), new_kv, conv_state


def setup_inputs(seed: int = 0) -> dict:
    key = jax.random.key(seed)
    ks = jax.random.split(key, 20)

    def nrm(k, shape, scale=1.0):
        return jax.random.normal(k, shape, jnp.float32) * scale

    L = [min(w, PAST_LEN) for w, _ in PATTERNS]
    return {
        'x_prompt': nrm(ks[0], (BATCH, SEQ, D_MODEL)),
        'x_sample': nrm(ks[1], (DEC_BATCH, DEC_SEQ, D_MODEL)),
        'state_hgrn': nrm(ks[2], (DEPTH, DEC_BATCH, H_A, DK_A, DV_A), 0.5),
        'cache_kv_g0': nrm(ks[3], (DEPTH, DEC_BATCH, L[0], 2, HPG, HEAD_DIM)),
        'cache_kv_g1': nrm(ks[4], (DEPTH, DEC_BATCH, L[1], 2, HPG, HEAD_DIM)),
        'cache_kv_g2': nrm(ks[5], (DEPTH, DEC_BATCH, L[2], 2, HPG, HEAD_DIM)),
        'state_ffn_conv': nrm(ks[6], (DEPTH, DEC_BATCH, CONV_W - 1, 2 * D_FF)),
        'norm_mix_w': 1.0 + nrm(ks[7], (DEPTH, D_MODEL), 0.02),
        'w_in': nrm(ks[8], (DEPTH, D_MODEL, N_IN), D_MODEL ** -0.5),
        'lb_logits': nrm(ks[9], (DEPTH + 1, W_AK), 0.5),
        'hgrn_norm_w': 1.0 + nrm(ks[10], (DEPTH, W_AV), 0.02),
        'w_proj_a': nrm(ks[11], (DEPTH, W_AV, D_MODEL), W_AV ** -0.5),
        'w_proj_b': nrm(ks[12], (DEPTH, W_B_OUT, D_MODEL), W_B_OUT ** -0.5),
        'w_out': nrm(ks[13], (DEPTH, D_MODEL, D_MODEL), D_MODEL ** -0.5),
        'norm_ffn_w': 1.0 + nrm(ks[14], (DEPTH, D_MODEL), 0.02),
        'w_up': nrm(ks[15], (DEPTH, D_MODEL, 2 * D_FF), D_MODEL ** -0.5),
        'ffn_conv_w': nrm(ks[16], (DEPTH, CONV_W, 2 * D_FF), CONV_W ** -0.5),
        'ffn_conv_b': nrm(ks[17], (DEPTH, 2 * D_FF), 0.02),
        'w_down': nrm(ks[18], (DEPTH, D_FF, D_MODEL), D_FF ** -0.5),
        'norm_final_w': 1.0 + nrm(ks[19], (D_MODEL,), 0.02),
    }


def reference(x_prompt, x_sample, state_hgrn, cache_kv_g0, cache_kv_g1, cache_kv_g2, state_ffn_conv,
              norm_mix_w, w_in, lb_logits, hgrn_norm_w, w_proj_a, w_proj_b, w_out, norm_ffn_w,
              w_up, ffn_conv_w, ffn_conv_b, w_down, norm_final_w):
    slopes = alibi_slopes()
    lb_all = jnp.cumsum(jax.nn.softmax(lb_logits.astype(jnp.float32), axis=0), axis=0)
    xp, xs = x_prompt, x_sample
    Bp = xp.shape[0]
    hg_p, hg_s, kv0_p, kv0_s, kv1_p, kv1_s, kv2_p, kv2_s, cv_p, cv_s = ([] for _ in range(10))
    for l in range(DEPTH):
        params = (norm_mix_w[l], w_in[l], lb_all[l], hgrn_norm_w[l], w_proj_a[l], w_proj_b[l], w_out[l],
                  norm_ffn_w[l], w_up[l], ffn_conv_w[l], ffn_conv_b[l], w_down[l], slopes)
        S0p = jnp.zeros((Bp, H_A, DK_A, DV_A), jnp.float32)
        conv0p = jnp.zeros((Bp, CONV_W - 1, 2 * D_FF), xp.dtype)
        xp, Sp, kvp, cp = trunk_layer(xp, S0p, None, conv0p, *params)
        xs, Ss, kvs, cs = trunk_layer(xs, state_hgrn[l], (cache_kv_g0[l], cache_kv_g1[l], cache_kv_g2[l]),
                                      state_ffn_conv[l], *params)
        hg_p.append(Sp); hg_s.append(Ss)
        kv0_p.append(kvp[0]); kv0_s.append(kvs[0])
        kv1_p.append(kvp[1]); kv1_s.append(kvs[1])
        kv2_p.append(kvp[2]); kv2_s.append(kvs[2])
        cv_p.append(cp); cv_s.append(cs)
    y_prompt = rmsnorm(xp, norm_final_w)
    y_sample = rmsnorm(xs, norm_final_w)
    return (y_prompt, y_sample, jnp.stack(hg_p), jnp.stack(hg_s), jnp.stack(kv0_p), jnp.stack(kv0_s),
            jnp.stack(kv1_p), jnp.stack(kv1_s), jnp.stack(kv2_p), jnp.stack(kv2_s),
            jnp.stack(cv_p), jnp.stack(cv_s))
```

```cpp
#include <hip/hip_runtime.h>
#include <hip/hip_cooperative_groups.h>
#include <cstdio>
#include <cstdint>
namespace cg = cooperative_groups;
#define LAS __attribute__((address_space(3)))
__device__ __forceinline__ int otid(int wv) { int t; asm volatile("v_mbcnt_lo_u32_b32 %0, -1, 0\n\tv_mbcnt_hi_u32_b32 %0, -1, %0" : "=v"(t)); return (wv << 6) | t; }
__device__ __forceinline__ float shx(float v, int mask, int lane) { return __int_as_float(__builtin_amdgcn_ds_bpermute((lane ^ mask) << 2, __float_as_int(v))); }
__device__ __forceinline__ float shl(float v, int src) { return __int_as_float(__builtin_amdgcn_ds_bpermute(src << 2, __float_as_int(v))); }
__device__ __forceinline__ unsigned shlu(unsigned v, int src) { return (unsigned)__builtin_amdgcn_ds_bpermute(src << 2, (int)v); }
namespace pg8 {
#define PG8_LAS __attribute__((address_space(3)))
typedef unsigned short bf16_t;
typedef short bf16x8 __attribute__((ext_vector_type(8)));
typedef float f32x4 __attribute__((ext_vector_type(4)));
typedef unsigned u32x4 __attribute__((ext_vector_type(4)));
constexpr int BM = 256, BK = 64, HALF = 128, HTB = HALF * BK * 2  , STAGE_BYTES = 8 * HTB, NXCD = 8, WGM = 8;

__host__ __device__ __forceinline__ int lds_byte(int r, int c) { const int st = (r >> 4) * 2 + (c >> 5), rr = r & 15, cc = c & 31, ob = rr * 64 + cc * 2; return st * 1024 + (ob ^ (((ob >> 9) & 1) << 5)); }
__host__ __device__ __forceinline__ void stage_rc(int b, int& R, int& C) { const int st = b / 1024, sb = b % 1024, swz = sb ^ (((sb >> 9) & 1) << 5); R = (st >> 1) * 16 + swz / 64; C = (st & 1) * 32 + (swz % 64) / 2; }
__host__ __device__ __forceinline__ int perm32(int rho) { const int n = rho >> 4, i = rho & 15; return 8 * (i >> 2) + 4 * n + (i & 3); }

struct Unit { int pm, pn, ks, kt0, nkt; };
struct Gemm { const bf16_t* A; const bf16_t* Bt; int M, N, K, a_rows; };

struct StaticOrder {
    static constexpr bool HALVES = false;
    int nM, nN, nwg, G, c;
    __host__ __device__ void init(int M, int N, int G_, int c_) { nM = M / BM; nN = N / BM; nwg = nM * nN; G = G_; c = c_; }
    __host__ __device__ bool next(int i, Unit& u) const {
        const long L = (long)i * G + c; if (L >= nwg) return false;
        int wgid = (int)L; { const int q = nwg / NXCD, r = nwg % NXCD, xcd = wgid % NXCD, off = wgid / NXCD; wgid = (xcd < r ? xcd * (q + 1) : r * (q + 1) + (xcd - r) * q) + off; }
        const int nig = WGM * nN, gid = wgid / nig, fm = gid * WGM, gsz = (nM - fm) < WGM ? (nM - fm) : WGM;
        u.pm = fm + ((wgid % nig) % gsz); u.pn = (wgid % nig) / gsz; u.ks = -1; u.kt0 = 0; u.nkt = 0; return true;
    }
    __device__ __forceinline__ void a_ready(const Unit&) const {}
    __device__ __forceinline__ void done(const Unit&) const {}
};
struct TailHalves {
    static constexpr bool HALVES = true;
    StaticOrder base; int nN, nMf;
    __host__ __device__ void init(int M, int N, int G_, int c_) { base.init(M - BM, N, G_, c_); nN = N / BM; nMf = M / BM - 1; }
    __host__ __device__ bool next(int i, Unit& u) const {
        const long L = (long)i * base.G + base.c; if (L < base.nwg) return base.next(i, u);
        const int j = (int)(L - base.nwg); if (j >= nN * 2) return false;
        u.pm = nMf; u.pn = j >> 1; u.ks = -2 - (j & 1); u.kt0 = 0; u.nkt = 0; return true;
    }
    __device__ __forceinline__ void a_ready(const Unit&) const {}
    __device__ __forceinline__ void done(const Unit&) const {}
};
struct TailOrder {
    static constexpr bool HALVES = false;
    StaticOrder base; int nN, nMf, KS, nkt;
    __host__ __device__ void init(int M, int N, int K, int KS_, int G_, int c_) { base.init(M - BM, N, G_, c_); nN = N / BM; nMf = M / BM - 1; KS = KS_; nkt = (K / BK) / KS_; }
    __host__ __device__ bool next(int i, Unit& u) const {
        const long L = (long)i * base.G + base.c; if (L < base.nwg) return base.next(i, u);
        const int j = (int)(L - base.nwg); if (j >= nN * KS) return false;
        u.pm = nMf; u.pn = j / KS; if (KS == 1) { u.ks = -1; u.kt0 = 0; u.nkt = 0; } else { u.ks = j % KS; u.kt0 = u.ks * nkt; u.nkt = nkt; } return true;
    }
    __device__ __forceinline__ void a_ready(const Unit&) const {}
    __device__ __forceinline__ void done(const Unit&) const {}
};
__device__ __forceinline__ unsigned cvt_pk_bf16(float lo, float hi) { unsigned r; asm volatile("v_cvt_pk_bf16_f32 %0, %1, %2" : "=v"(r) : "v"(lo), "v"(hi)); return r; }
struct EpiBf16 {
    static constexpr bool PERM = true, AFTER_DRAIN = false; static constexpr int MIDK = 0;
    bf16_t* O; int ldc, pad_;
    __device__ __forceinline__ void operator()(const f32x4 (&acc)[2][2][4][2], const Unit& u, int wr, int wc, int fr, int fq) const {
        const int row0 = u.pm * BM + wr * 64 + fr; const int col0 = u.pn * BM + wc * 32 + 8 * fq;
#pragma unroll
        for (int ai = 0; ai < 2; ++ai)
#pragma unroll
            for (int m = 0; m < 4; ++m) { bf16_t* rowp = O + (size_t)(row0 + ai * HALF + m * 16) * ldc + col0;
#pragma unroll
                for (int bj = 0; bj < 2; ++bj) { const f32x4 v0 = acc[ai][bj][m][0], v1 = acc[ai][bj][m][1];
                    u32x4 w; w.x = cvt_pk_bf16(v0[0], v0[1]); w.y = cvt_pk_bf16(v0[2], v0[3]); w.z = cvt_pk_bf16(v1[0], v1[1]); w.w = cvt_pk_bf16(v1[2], v1[3]);
                    *(u32x4*)(rowp + bj * HALF) = w; } }
    }
};
struct EpiF32 {
    static constexpr bool PERM = false, AFTER_DRAIN = false; static constexpr int MIDK = 0;
    float* C; const float* bias; int ldc, pad_;
    __device__ __forceinline__ void operator()(const f32x4 (&acc)[2][2][4][2], const Unit& u, int wr, int wc, int fr, int fq) const {
        const int row0 = u.pm * BM + wr * 64 + fr, col0 = u.pn * BM + wc * 32 + 4 * fq;
        f32x4 bv[2][2];
#pragma unroll
        for (int bj = 0; bj < 2; ++bj)
#pragma unroll
            for (int n = 0; n < 2; ++n) bv[bj][n] = bias ? *(const f32x4*)(bias + col0 + bj * HALF + n * 16) : (f32x4){0.f, 0.f, 0.f, 0.f};
#pragma unroll
        for (int ai = 0; ai < 2; ++ai)
#pragma unroll
            for (int m = 0; m < 4; ++m) { float* rowp = C + (size_t)(row0 + ai * HALF + m * 16) * ldc + col0;
#pragma unroll
                for (int bj = 0; bj < 2; ++bj)
#pragma unroll
                    for (int n = 0; n < 2; ++n) *(f32x4*)(rowp + bj * HALF + n * 16) = acc[ai][bj][m][n] + bv[bj][n]; }
    }
};
typedef unsigned u32x2 __attribute__((ext_vector_type(2)));
__device__ __forceinline__ float fsigmoid(float z) { return __builtin_amdgcn_rcpf(1.f + __expf(-z)); }
__device__ __forceinline__ float bflo(unsigned w) { return __uint_as_float(w << 16); }
__device__ __forceinline__ float bfhi(unsigned w) { return __uint_as_float(w & 0xffff0000u); }
struct EpiInProj {
    static constexpr bool PERM = true, AFTER_DRAIN = false; static constexpr int MIDK = 0;
    bf16_t* Z; float* G32; const float* r1; const float* lbv; u32x4* GT;
    __device__ __forceinline__ void operator()(const f32x4 (&acc)[2][2][4][2], const Unit& u, int wr, int wc, int fr, int fq) const {
        asm volatile("" : "+v"(fr), "+v"(fq));
        const int pn = u.pn, mode = pn < 4 ? 1 : (pn < 8 ? 2 : (pn < 12 ? 0 : (pn < 16 ? 1 : (pn < 34 ? 0 : 3))));
        const int row0 = u.pm * BM + wr * 64 + fr, col0 = pn * BM + wc * 32 + 8 * fq;
        float rr[8];
#pragma unroll
        for (int q = 0; q < 8; ++q) rr[q] = r1[row0 + (q >> 2) * HALF + (q & 3) * 16];
        f32x4 lb[2][2];
        { const float* lp = lbv + (mode == 2 ? col0 - 1024 : (col0 & 511));
#pragma unroll
          for (int bj = 0; bj < 2; ++bj) { lb[bj][0] = *(const f32x4*)(lp + bj * HALF); lb[bj][1] = *(const f32x4*)(lp + bj * HALF + 4); } }
        asm volatile("" : "+v"(rr[0]), "+v"(rr[1]), "+v"(rr[2]), "+v"(rr[3]), "+v"(rr[4]), "+v"(rr[5]), "+v"(rr[6]), "+v"(rr[7]));
#pragma unroll
        for (int ai = 0; ai < 2; ++ai)
#pragma unroll
            for (int m = 0; m < 4; ++m) { if (u.pm == 64 && ai == 1) continue;     const int row = row0 + ai * HALF + m * 16; const float r = rr[ai * 4 + m]; bf16_t* rowp = Z + (size_t)row * 12800 + col0;
#pragma unroll
                for (int bj = 0; bj < 2; ++bj) { float v[8];
#pragma unroll
                    for (int j = 0; j < 8; ++j) v[j] = acc[ai][bj][m][j >> 2][j & 3] * r;
                    if (mode == 1) {
#pragma unroll
                        for (int j = 0; j < 8; ++j) v[j] = v[j] * fsigmoid(v[j]);
                    } else if (mode == 3) {
#pragma unroll
                        for (int j = 0; j < 8; ++j) v[j] = fsigmoid(v[j]);
                    } else if (mode == 2) { float gl[8];
#pragma unroll
                        for (int j = 0; j < 8; ++j) { const float k = (1.f - lb[bj][j >> 2][j & 3]) * __builtin_amdgcn_rcpf(1.f + __expf(v[j])); gl[j] = __logf(1.f - k); v[j] = k; }
                        float* gp = G32 + (size_t)row * 1024 + (col0 - 1024) + bj * HALF; *(f32x4*)gp = (f32x4){gl[0], gl[1], gl[2], gl[3]}; *(f32x4*)(gp + 4) = (f32x4){gl[4], gl[5], gl[6], gl[7]}; }
                    u32x4 w; w.x = cvt_pk_bf16(v[0], v[1]); w.y = cvt_pk_bf16(v[2], v[3]); w.z = cvt_pk_bf16(v[4], v[5]); w.w = cvt_pk_bf16(v[6], v[7]);
                    if (mode == 3) GT[((size_t)(u.pm * 16 + (pn - 34)) * 16 + (ai * 4 + m) * 2 + bj) * 512 + (wr * 4 + wc) * 64 + fq * 16 + fr] = w;
                    else *(u32x4*)(rowp + bj * HALF) = w; } }
    }
};
template <int STEP> struct EpiMix {
    static constexpr bool PERM = false, AFTER_DRAIN = false; static constexpr int MIDK = 0;
    const bf16_t* Zg; float* C; bf16_t* MIX;
    __device__ __forceinline__ void operator()(const f32x4 (&acc)[2][2][4][2], const Unit& u, int wr, int wc, int fr, int fq) const {
        asm volatile("" : "+v"(fr), "+v"(fq));
        const int row0 = u.pm * BM + wr * 64 + fr, col0 = u.pn * BM + wc * 32 + 4 * fq;
#pragma unroll
        for (int ai = 0; ai < 2; ++ai)
#pragma unroll
            for (int m = 0; m < 4; ++m) { if (u.pm == 64 && ai == 1) continue;     const int row = row0 + ai * HALF + m * 16;
#pragma unroll
                for (int bj = 0; bj < 2; ++bj)
#pragma unroll
                    for (int n = 0; n < 2; ++n) { const int col = col0 + bj * HALF + n * 16; const u32x2 gw = *(const u32x2*)(Zg + (size_t)row * 12800 + col);
                        const f32x4 g = (f32x4){bflo(gw.x), bfhi(gw.x), bflo(gw.y), bfhi(gw.y)}; float* cp = C + (size_t)row * 2048 + col;
                        if (STEP == 0) *(f32x4*)cp = g * acc[ai][bj][m][n];
                        else { const f32x4 v = *(const f32x4*)cp + g * acc[ai][bj][m][n]; *(u32x2*)(MIX + (size_t)row * 2048 + col) = (u32x2){cvt_pk_bf16(v[0], v[1]), cvt_pk_bf16(v[2], v[3])}; } } }
    }
};
template <bool WITH_BF16> struct EpiResid {
    static constexpr bool PERM = true, AFTER_DRAIN = false; static constexpr int MIDK = 0;
    const float* xp; const float* xs; float* out; bf16_t* XB; float* SSP; float* slab; f32x4* X1T;
    __device__ __forceinline__ void operator()(const f32x4 (&acc)[2][2][4][2], const Unit& u, int wr, int wc, int fr, int fq) const {
        asm volatile("" : "+v"(fr), "+v"(fq));
        const int row0 = u.pm * BM + wr * 64 + fr, col0 = u.pn * BM + wc * 32 + 8 * fq;
        f32x4* const xt = X1T + (size_t)(u.pm * 8 + u.pn) * 32 * 512 + (wr * 4 + wc) * 64 + fq * 16 + fr;
        if (u.ks >= 0) {
#pragma unroll
            for (int m = 0; m < 4; ++m) { float* sp = slab + ((size_t)u.ks * 128 + wr * 64 + m * 16 + fr) * 2048 + col0;
#pragma unroll
                for (int bj = 0; bj < 2; ++bj)
#pragma unroll
                    for (int n = 0; n < 2; ++n) *(f32x4*)(sp + bj * HALF + n * 4) = acc[0][bj][m][n]; }
            return; }
#pragma unroll
        for (int ai = 0; ai < 2; ++ai) { if (u.pm == 64 && ai == 1) continue;
            constexpr int MB = WITH_BF16 ? 2 : 4;
#pragma unroll
            for (int mp = 0; mp < 4 / MB; ++mp) {
            f32x4 bs[MB][2][2]; u32x4 bx[MB][2];
#pragma unroll
            for (int mm = 0; mm < MB; ++mm) { const int row = row0 + ai * HALF + (MB * mp + mm) * 16; const float* bp = (row < 16384 ? xp + (size_t)row * 2048 : xs + (size_t)(row - 16384) * 2048) + col0;
#pragma unroll
                for (int bj = 0; bj < 2; ++bj) {
                    if (WITH_BF16) {
#pragma unroll
                        for (int n = 0; n < 2; ++n) bs[mm][bj][n] = row < 16512 ? *(const f32x4*)(bp + bj * HALF + n * 4) : (f32x4){0.f, 0.f, 0.f, 0.f};
                    } else bx[mm][bj] = *(const u32x4*)(XB + (size_t)row * 2048 + col0 + bj * HALF); } }
#pragma unroll
            for (int mm = 0; mm < MB; ++mm) { const int m = MB * mp + mm, row = row0 + ai * HALF + m * 16; float ss = 0.f;
                if (row < 16512) { float* op = (row < 16384 ? out + (size_t)row * 2048 : out + 33554432 + (size_t)(row - 16384) * 2048) + col0;
#pragma unroll
                    for (int bj = 0; bj < 2; ++bj)
                    { f32x4 v[2];
                        if (!WITH_BF16) { const u32x4 x = bx[mm][bj]; bs[mm][bj][0] = (f32x4){bflo(x.x), bfhi(x.x), bflo(x.y), bfhi(x.y)}; bs[mm][bj][1] = (f32x4){bflo(x.z), bfhi(x.z), bflo(x.w), bfhi(x.w)}; }
#pragma unroll
                        for (int n = 0; n < 2; ++n) { v[n] = bs[mm][bj][n] + acc[ai][bj][m][n]; ss += v[n][0] * v[n][0] + v[n][1] * v[n][1] + v[n][2] * v[n][2] + v[n][3] * v[n][3];
                            if (!WITH_BF16) *(f32x4*)(op + bj * HALF + n * 4) = v[n]; }
                        if (WITH_BF16) *(u32x4*)(XB + (size_t)row * 2048 + col0 + bj * HALF) = (u32x4){cvt_pk_bf16(v[0][0], v[0][1]), cvt_pk_bf16(v[0][2], v[0][3]), cvt_pk_bf16(v[1][0], v[1][1]), cvt_pk_bf16(v[1][2], v[1][3])}; } }
                ss += shx(ss, 16, fq * 16 + fr); ss += shx(ss, 32, fq * 16 + fr);
                if (fq == 0) SSP[(size_t)row * 32 + 4 * u.pn + wc] = ss; }
            asm volatile("" ::: "memory"); } }
    }
};
struct EpiMixCat {
    static constexpr bool PERM = true, AFTER_DRAIN = false; static constexpr int MIDK = 16;
    const u32x4* GT; bf16_t* MIX;
    __device__ __forceinline__ void mid(f32x4 (&acc)[2][2][4][2], const Unit& u, int wr, int wc, int fr, int fq) const {
        asm volatile("" : "+v"(fr), "+v"(fq));
        const int row0 = u.pm * BM + wr * 64 + fr, col0 = u.pn * BM + wc * 32 + 8 * fq, gtid = (wr * 4 + wc) * 64 + fq * 16 + fr;
        const size_t ga0 = (size_t)(u.pm * 16 + u.pn) * 16 * 512, gb0 = (size_t)(u.pm * 16 + 8 + u.pn) * 16 * 512;
#pragma unroll
        for (int ai = 0; ai < 2; ++ai) { if (u.pm == 64 && ai == 1) continue;
#pragma unroll
            for (int mp = 0; mp < 2; ++mp) {
            u32x4 ga[2][2], gb[2][2];
#pragma unroll
            for (int mm = 0; mm < 2; ++mm)
#pragma unroll
                for (int bj = 0; bj < 2; ++bj) { const size_t ge = ((size_t)(ai * 4 + 2 * mp + mm) * 2 + bj) * 512 + gtid; ga[mm][bj] = GT[ga0 + ge]; gb[mm][bj] = GT[gb0 + ge]; }
#pragma unroll
            for (int mm = 0; mm < 2; ++mm)
#pragma unroll
                for (int bj = 0; bj < 2; ++bj) { const int m = 2 * mp + mm; const unsigned aw[4] = {ga[mm][bj].x, ga[mm][bj].y, ga[mm][bj].z, ga[mm][bj].w}, bw[4] = {gb[mm][bj].x, gb[mm][bj].y, gb[mm][bj].z, gb[mm][bj].w};
#pragma unroll
                    for (int q = 0; q < 4; ++q) { acc[ai][bj][m][q >> 1][2 * (q & 1)] *= bflo(aw[q]) * __builtin_amdgcn_rcpf(bflo(bw[q])); acc[ai][bj][m][q >> 1][2 * (q & 1) + 1] *= bfhi(aw[q]) * __builtin_amdgcn_rcpf(bfhi(bw[q])); } }
            asm volatile("" ::: "memory"); } }
    }
    __device__ __forceinline__ void operator()(const f32x4 (&acc)[2][2][4][2], const Unit& u, int wr, int wc, int fr, int fq) const {
        asm volatile("" : "+v"(fr), "+v"(fq));
        const int row0 = u.pm * BM + wr * 64 + fr, col0 = u.pn * BM + wc * 32 + 8 * fq, gtid = (wr * 4 + wc) * 64 + fq * 16 + fr;
        const size_t ga0 = (size_t)(u.pm * 16 + u.pn) * 16 * 512, gb0 = (size_t)(u.pm * 16 + 8 + u.pn) * 16 * 512;
#pragma unroll
        for (int ai = 0; ai < 2; ++ai) { if (u.pm == 64 && ai == 1) continue;
            u32x4 gb[4][2];
#pragma unroll
            for (int m = 0; m < 4; ++m)
#pragma unroll
                for (int bj = 0; bj < 2; ++bj) gb[m][bj] = GT[gb0 + ((size_t)(ai * 4 + m) * 2 + bj) * 512 + gtid];
#pragma unroll
            for (int m = 0; m < 4; ++m) { const int row = row0 + ai * HALF + m * 16;
#pragma unroll
                for (int bj = 0; bj < 2; ++bj) { const u32x4 g = gb[m][bj]; const f32x4 v0 = acc[ai][bj][m][0], v1 = acc[ai][bj][m][1];
                    u32x4 w; w.x = cvt_pk_bf16(v0[0] * bflo(g.x), v0[1] * bfhi(g.x)); w.y = cvt_pk_bf16(v0[2] * bflo(g.y), v0[3] * bfhi(g.y));
                    w.z = cvt_pk_bf16(v1[0] * bflo(g.z), v1[1] * bfhi(g.z)); w.w = cvt_pk_bf16(v1[2] * bflo(g.w), v1[3] * bfhi(g.w));
                    *(u32x4*)(MIX + (size_t)row * 2048 + col0 + bj * HALF) = w; } }
            asm volatile("" ::: "memory"); }
    }
};
struct EpiConv {
    static constexpr bool PERM = true, AFTER_DRAIN = false; static constexpr int MIDK = 0;
    bf16_t* ACT; const float* R2; const float* cbuf; const float* cw; const float* cb; float* out; PG8_LAS unsigned char* xch;
    __device__ __forceinline__ void operator()(const f32x4 (&acc)[2][2][4][2], const Unit& u, int wr, int wc, int fr, int fq) const {
        asm volatile("" : "+v"(fr), "+v"(fq));
        const int pm = u.pm, pn = u.pn, lane = fq * 16 + fr, c0 = 128 * pn + 32 * wc + 8 * fq;
        const bool only0 = u.ks <= -2, smpu = u.ks == -3; const int org = 254 * pm + (smpu ? 128 : 0);
        const bool smp_tile = pm == 64 && !only0;
        u32x4 pk[2][4][2]; u32x2 pa[2][4];
        float rr[8];
#pragma unroll
        for (int q = 0; q < 8; ++q) rr[q] = R2[org + 128 * (q >> 2) + 64 * wr + 16 * (q & 3) + fr];
        asm volatile("" : "+v"(rr[0]), "+v"(rr[1]), "+v"(rr[2]), "+v"(rr[3]), "+v"(rr[4]), "+v"(rr[5]), "+v"(rr[6]), "+v"(rr[7]));
#pragma unroll
        for (int ai = 0; ai < 2; ++ai)
#pragma unroll
            for (int m = 0; m < 4; ++m) { const float r = rr[ai * 4 + m];
#pragma unroll
                for (int n = 0; n < 2; ++n) { const f32x4 g = acc[ai][0][m][n] * r, a = acc[ai][1][m][n] * r;
                    pk[ai][m][n] = (u32x4){cvt_pk_bf16(g[0], g[1]), cvt_pk_bf16(g[2], g[3]), cvt_pk_bf16(a[0], a[1]), cvt_pk_bf16(a[2], a[3])}; } }
        if (fr >= 14) {
#pragma unroll
            for (int ai = 0; ai < 2; ++ai)
#pragma unroll
                for (int n = 0; n < 2; ++n) *(PG8_LAS u32x4*)(xch + ((((((ai * 2 + wr) * 2 + (fr - 14)) * 4 + wc) * 4 + fq) * 2 + n) * 16)) = pk[ai][3][n]; }
        asm volatile("s_waitcnt lgkmcnt(0)" ::: "memory"); __builtin_amdgcn_s_barrier(); asm volatile("" ::: "memory");
#pragma unroll
        for (int n = 0; n < 2; ++n) {
            const int cn = c0 + 4 * n;
            float w0[8], w1[8], w2[8], bb[8];
#pragma unroll
            for (int hf = 0; hf < 2; ++hf) { const int col = cn + hf * 5632; const f32x4 a0 = *(const f32x4*)(cw + col), a1 = *(const f32x4*)(cw + 11264 + col), a2 = *(const f32x4*)(cw + 22528 + col), a3 = *(const f32x4*)(cb + col);
#pragma unroll
                for (int e = 0; e < 4; ++e) { w0[hf * 4 + e] = a0[e]; w1[hf * 4 + e] = a1[e]; w2[hf * 4 + e] = a2[e]; bb[hf * 4 + e] = a3[e]; } }
#pragma unroll
            for (int ai = 0; ai < 2; ++ai) { if (only0 && ai == 1) continue;
                const int seg = ai * 2 + wr; const bool smp = smpu || (smp_tile && ai == 1);
                u32x4 prev = seg > 0 ? *(const PG8_LAS u32x4*)(xch + (((((((seg - 1) * 2 + (fr & 1)) * 4 + wc) * 4 + fq) * 2 + n) * 16))) : (u32x4){0u, 0u, 0u, 0u};
#pragma unroll
                for (int m = 0; m < 4; ++m) {
                    const int lr = 128 * ai + 64 * wr + 16 * m + fr, grow = org + lr;
                    const u32x4 cur = pk[ai][m][n]; u32x4 s1, s2;
#pragma unroll
                    for (int e = 0; e < 4; ++e) { const unsigned m1 = fr == 15 ? prev[e] : cur[e], m2 = fr >= 14 ? prev[e] : cur[e];
                        s1[e] = (unsigned)__builtin_amdgcn_update_dpp(0, (int)m1, 0x121, 0xf, 0xf, false); s2[e] = (unsigned)__builtin_amdgcn_update_dpp(0, (int)m2, 0x122, 0xf, 0xf, false); }
                    prev = cur;
                    float uc[8], u1[8], u2[8];
#pragma unroll
                    for (int q = 0; q < 4; ++q) { uc[2 * q] = bflo(cur[q]); uc[2 * q + 1] = bfhi(cur[q]); u1[2 * q] = bflo(s1[q]); u1[2 * q + 1] = bfhi(s1[q]); u2[2 * q] = bflo(s2[q]); u2[2 * q + 1] = bfhi(s2[q]); }
                    if (smp) {
                        const int s = fr & 3, b = (64 * wr + 16 * m + fr) >> 2;
                        if (s < 2) {
#pragma unroll
                            for (int hf = 0; hf < 2; ++hf) { const int col = cn + hf * 5632; const f32x4 b0 = *(const f32x4*)(cbuf + ((size_t)b * 2 + 0) * 11264 + col), b1 = *(const f32x4*)(cbuf + ((size_t)b * 2 + 1) * 11264 + col);
#pragma unroll
                                for (int e = 0; e < 4; ++e) { const int j = hf * 4 + e; if (s == 0) { u1[j] = b1[e]; u2[j] = b0[e]; } else { u2[j] = b1[e]; } } } }
                    }
                    float av[4];
#pragma unroll
                    for (int j = 0; j < 4; ++j) { const float cg = bb[j] + w0[j] * u2[j] + w1[j] * u1[j] + w2[j] * uc[j], ca = bb[4 + j] + w0[4 + j] * u2[4 + j] + w1[4 + j] * u1[4 + j] + w2[4 + j] * uc[4 + j];
                        av[j] = cg * fsigmoid(cg) * ca; }
                    const bool valid = smp || pm == 0 || lr >= 2;
                    if (n == 0) pa[ai][m] = (u32x2){cvt_pk_bf16(av[0], av[1]), cvt_pk_bf16(av[2], av[3])};
                    else if (valid) *(u32x4*)(ACT + (size_t)grow * 5632 + c0) = (u32x4){pa[ai][m].x, pa[ai][m].y, cvt_pk_bf16(av[0], av[1]), cvt_pk_bf16(av[2], av[3])};
                    float* so = nullptr;
                    if (smp) { if ((fr & 3) >= 2) so = out + 128997376 + ((size_t)((64 * wr + 16 * m + fr) >> 2) * 2 + ((fr & 3) - 2)) * 11264; }
                    else if (grow >= 16382 && grow < 16384) so = out + 128974848 + (size_t)(grow - 16382) * 11264;
                    if (so) { *(f32x4*)(so + cn) = (f32x4){uc[0], uc[1], uc[2], uc[3]}; *(f32x4*)(so + cn + 5632) = (f32x4){uc[4], uc[5], uc[6], uc[7]}; }
                    asm volatile("" ::: "memory");
                }
            }
        }
    }
};
template <class Epi, class Sched, bool ALIGN_EPI = false, bool SP2 = false>
__device__ __forceinline__ void gemm_phase(PG8_LAS unsigned char* lds, const Gemm g, const Sched& S, const Epi& E, int wv) {
    const int tid = otid(wv), wid = __builtin_amdgcn_readfirstlane(tid >> 6), lane = tid & 63, wr = wid >> 2, wc = wid & 3, fr = lane & 15, fq = lane >> 4;
    const int K = g.K, nt = K / BK;
    unsigned voffA[2], voffB[2];
#pragma unroll
    for (int i = 0; i < 2; ++i) { int R, C; stage_rc(tid * 16 + i * 8192, R, C); const int Rb = Epi::PERM ? ((R & ~31) + perm32(R & 31)) : R;
        voffA[i] = (unsigned)(R * K + C) * 2u; voffB[i] = (unsigned)(Rb * K + C) * 2u; }
    const size_t kstep = (size_t)(BK * 2);
    const size_t hstep = (size_t)HALF * K * 2;
    const size_t tstep = 2 * hstep;
    const size_t tstepA = (size_t)g.a_rows * K * 2;
    const unsigned ldsw = (unsigned)wid * 1024u;
    const int aoff = lds_byte(wr * 64 + fr, fq * 8), boff = lds_byte(wc * 32 + fr, fq * 8);
#define PG8_SA(b, h) (((b) * 2 + (h)) * HTB)
#define PG8_SB(b, h) ((4 + (b) * 2 + (h)) * HTB)
#define PG8_STAGE(bufoff, gbase, voff) do { _Pragma("unroll") for (int _i = 0; _i < 2; ++_i) \
        __builtin_amdgcn_global_load_lds((const unsigned*)((const char*)(gbase) + (voff)[_i]), (PG8_LAS unsigned*)(lds + (bufoff) + ldsw + _i * 8192), 16, 0, 0); } while (0)
#define PG8_LDA(dst, b, h) do { _Pragma("unroll") for (int m = 0; m < 4; ++m) _Pragma("unroll") for (int k = 0; k < 2; ++k) dst[m][k] = *(const PG8_LAS bf16x8*)(lds + PG8_SA(b, h) + aoff + m * 2048 + k * 1024); } while (0)
#define PG8_LDB(dst, b, h) do { _Pragma("unroll") for (int n = 0; n < 2; ++n) _Pragma("unroll") for (int k = 0; k < 2; ++k) dst[n][k] = *(const PG8_LAS bf16x8*)(lds + PG8_SB(b, h) + boff + n * 2048 + k * 1024); } while (0)
#define PG8_MMA(ai, bj, At, Bt) do { __builtin_amdgcn_s_setprio(1); _Pragma("unroll") for (int m = 0; m < 4; ++m) _Pragma("unroll") for (int n = 0; n < 2; ++n) _Pragma("unroll") for (int k = 0; k < 2; ++k) \
        acc[ai][bj][m][n] = __builtin_amdgcn_mfma_f32_16x16x32_bf16(Bt[n][k], At[m][k], acc[ai][bj][m][n], 0, 0, 0); __builtin_amdgcn_s_setprio(0); } while (0)
#define PG8_WAIT_V(n) asm volatile("s_waitcnt vmcnt(" #n ")" ::: "memory")
#define PG8_WAIT_L(n) asm volatile("s_waitcnt lgkmcnt(" #n ")" ::: "memory")
#define PG8_BAR __builtin_amdgcn_s_barrier()
#define PG8_SCHED __builtin_amdgcn_sched_barrier(0)
    Unit cur, nxt; int ui = 0;
    if (!S.next(0, cur)) return;
    f32x4 acc[2][2][4][2];
#pragma unroll
    for (int a = 0; a < 2; ++a)
#pragma unroll
        for (int b = 0; b < 2; ++b)
#pragma unroll
            for (int m = 0; m < 4; ++m)
#pragma unroll
                for (int n = 0; n < 2; ++n) acc[a][b][m][n] = (f32x4){0.f, 0.f, 0.f, 0.f};
    bf16x8 At[4][2], B0[2][2], B1[2][2];
    const size_t sh3 = (size_t)HALF * K * 2;
    const char* cA = (const char*)g.A + (size_t)cur.pm * tstepA + (size_t)cur.kt0 * kstep + (Sched::HALVES && cur.ks == -3 ? sh3 : (size_t)0); const char* cB = (const char*)g.Bt + (size_t)cur.pn * tstep + (size_t)cur.kt0 * kstep;
    S.a_ready(cur);
    if constexpr (SP2) {
        PG8_STAGE(PG8_SB(0, 0), cB, voffB); PG8_STAGE(PG8_SB(0, 1), cB + hstep, voffB); PG8_STAGE(PG8_SA(0, 0), cA, voffA); PG8_STAGE(PG8_SA(0, 1), cA + hstep, voffA);
        if (wr == 1) PG8_BAR;
        PG8_WAIT_V(2); PG8_BAR;
        PG8_STAGE(PG8_SB(1, 0), cB + kstep, voffB); PG8_STAGE(PG8_SA(1, 0), cA + kstep, voffA); PG8_STAGE(PG8_SB(1, 1), cB + hstep + kstep, voffB);
        PG8_WAIT_V(6); PG8_BAR;
    } else {
        PG8_STAGE(PG8_SB(0, 0), cB, voffB); PG8_STAGE(PG8_SA(0, 0), cA, voffA); PG8_STAGE(PG8_SB(0, 1), cB + hstep, voffB); PG8_STAGE(PG8_SA(0, 1), cA + hstep, voffA);
        if (wr == 1) PG8_BAR;
        PG8_WAIT_V(4); PG8_BAR;
        PG8_STAGE(PG8_SB(1, 0), cB + kstep, voffB); PG8_STAGE(PG8_SA(1, 0), cA + kstep, voffA); PG8_STAGE(PG8_SB(1, 1), cB + hstep + kstep, voffB);
        PG8_WAIT_V(6); PG8_BAR;
    }
    for (;;) {
        const bool has_next = S.next(ui + 1, nxt);
        const bool half = Sched::HALVES ? cur.ks <= -2 : (g.a_rows == BM && cur.pm == g.M / BM - 1);
        const char* nA = has_next ? (const char*)g.A + (size_t)nxt.pm * tstepA + (size_t)nxt.kt0 * kstep + (Sched::HALVES && nxt.ks == -3 ? sh3 : (size_t)0) : cA; const char* nB = has_next ? (const char*)g.Bt + (size_t)nxt.pn * tstep + (size_t)nxt.kt0 * kstep : cB;
        const int ntc = cur.ks < 0 ? nt : cur.nkt;
        for (int t = 0; t < ntc; t += 2) {
            const bool last = (t == ntc - 2);
            if constexpr (Epi::MIDK > 0) { if (t == Epi::MIDK) E.mid(acc, cur, wr, wc, fr, fq); }
            const char* a1 = cA + (size_t)(t + 1) * kstep;
            const char* a2 = last ? nA : cA + (size_t)(t + 2) * kstep; const char* b2 = last ? nB : cB + (size_t)(t + 2) * kstep;
            const char* a3 = a2 + kstep; const char* b3 = b2 + kstep;
            if (last && has_next) S.a_ready(nxt);
            if constexpr (SP2) {
            PG8_LDB(B0, 0, 0); PG8_LDB(B1, 0, 1); PG8_SCHED; PG8_LDA(At, 0, 0); PG8_STAGE(PG8_SA(1, 1), a1 + hstep, voffA);
            PG8_WAIT_V(8); PG8_WAIT_L(0); PG8_BAR; PG8_MMA(0, 0, At, B0); PG8_MMA(0, 1, At, B1); PG8_BAR; PG8_SCHED;
            PG8_LDA(At, 0, 1); PG8_STAGE(PG8_SB(0, 0), b2, voffB); PG8_STAGE(PG8_SB(0, 1), b2 + hstep, voffB); PG8_STAGE(PG8_SA(0, 0), a2, voffA);
            PG8_WAIT_V(8); PG8_WAIT_L(0); PG8_BAR; if (!half) { PG8_MMA(1, 0, At, B0); PG8_MMA(1, 1, At, B1); } PG8_BAR; PG8_SCHED;
            PG8_LDB(B0, 1, 0); PG8_LDB(B1, 1, 1); PG8_SCHED; PG8_LDA(At, 1, 0); PG8_STAGE(PG8_SA(0, 1), a2 + hstep, voffA);
            PG8_WAIT_V(8); PG8_WAIT_L(0); PG8_BAR; PG8_MMA(0, 0, At, B0); PG8_MMA(0, 1, At, B1); PG8_BAR; PG8_SCHED;
            PG8_LDA(At, 1, 1); PG8_STAGE(PG8_SB(1, 0), b3, voffB); PG8_STAGE(PG8_SB(1, 1), b3 + hstep, voffB); PG8_STAGE(PG8_SA(1, 0), a3, voffA);
            PG8_WAIT_V(8); PG8_WAIT_L(0); PG8_BAR; if (!half) { PG8_MMA(1, 0, At, B0); PG8_MMA(1, 1, At, B1); } PG8_BAR; PG8_SCHED;
            } else {
            PG8_LDB(B0, 0, 0); PG8_SCHED; PG8_LDA(At, 0, 0); PG8_STAGE(PG8_SA(1, 1), a1 + hstep, voffA);
            PG8_WAIT_L(8); PG8_BAR; PG8_WAIT_L(0); PG8_MMA(0, 0, At, B0); PG8_BAR; PG8_SCHED;
            PG8_LDB(B1, 0, 1); PG8_STAGE(PG8_SB(0, 0), b2, voffB);
            PG8_BAR; PG8_WAIT_L(0); PG8_MMA(0, 1, At, B1); PG8_BAR;
            PG8_LDA(At, 0, 1); PG8_STAGE(PG8_SA(0, 0), a2, voffA);
            PG8_BAR; PG8_WAIT_L(0); PG8_MMA(1, 0, At, B0); PG8_BAR; PG8_SCHED;
            PG8_STAGE(PG8_SB(0, 1), b2 + hstep, voffB);
            PG8_WAIT_V(6); PG8_BAR; PG8_MMA(1, 1, At, B1); PG8_BAR;
            PG8_LDB(B0, 1, 0); PG8_SCHED; PG8_LDA(At, 1, 0); PG8_STAGE(PG8_SA(0, 1), a2 + hstep, voffA);
            PG8_WAIT_L(8); PG8_BAR; PG8_WAIT_L(0); PG8_MMA(0, 0, At, B0); PG8_BAR; PG8_SCHED;
            PG8_LDB(B1, 1, 1); PG8_STAGE(PG8_SB(1, 0), b3, voffB);
            PG8_BAR; PG8_WAIT_L(0); PG8_MMA(0, 1, At, B1); PG8_BAR;
            PG8_LDA(At, 1, 1); PG8_STAGE(PG8_SA(1, 0), a3, voffA);
            PG8_BAR; PG8_WAIT_L(0); PG8_MMA(1, 0, At, B0); PG8_BAR; PG8_SCHED;
            PG8_STAGE(PG8_SB(1, 1), b3 + hstep, voffB);
            PG8_WAIT_V(6); PG8_BAR; PG8_MMA(1, 1, At, B1); PG8_BAR;
            }
        }
        if constexpr (ALIGN_EPI) { if (wr == 0) PG8_BAR; }
        if constexpr (!Epi::AFTER_DRAIN) { E(acc, cur, wr, wc, fr, fq); S.done(cur); }
        if (!has_next) break;
#pragma unroll
        for (int a = 0; a < 2; ++a)
#pragma unroll
            for (int b = 0; b < 2; ++b)
#pragma unroll
                for (int m = 0; m < 4; ++m)
#pragma unroll
                    for (int n = 0; n < 2; ++n) acc[a][b][m][n] = (f32x4){0.f, 0.f, 0.f, 0.f};
        cur = nxt; cA = nA; cB = nB; ++ui;
        if constexpr (ALIGN_EPI) { if (wr == 1) PG8_BAR; }
    }
    PG8_WAIT_V(0);
    if constexpr (!ALIGN_EPI) { if (wr == 0) PG8_BAR; }
    PG8_BAR;
    if constexpr (Epi::AFTER_DRAIN) { E.fused(acc, cur, wr, wc, fr, fq, lds, wid, lane); S.done(cur); }
#undef PG8_SA
#undef PG8_SB
#undef PG8_STAGE
#undef PG8_LDA
#undef PG8_LDB
#undef PG8_MMA
#undef PG8_WAIT_V
#undef PG8_WAIT_L
#undef PG8_BAR
#undef PG8_SCHED
}
}
#define XB_TMO      128
#define XB_XCNT(j)  (256  + 64 * (j))
#define XB_XSUB(j)  (1280 + 64 * (j))
#define XB_XGEN(j)  (2304 + 64 * (j))
#define XB_TOP      3328
#define XB_TOPGEN   3392
#define XCD_BAR_WORDS 3456
#define XB_SPIN_CAP (1u << 18)

__device__ __forceinline__ unsigned xb_ld(unsigned* p)              { return __hip_atomic_load(p, __ATOMIC_RELAXED, __HIP_MEMORY_SCOPE_AGENT); }
__device__ __forceinline__ unsigned xb_add(unsigned* p, unsigned v) { return __hip_atomic_fetch_add(p, v, __ATOMIC_RELAXED, __HIP_MEMORY_SCOPE_AGENT); }
__device__ __forceinline__ unsigned xb_xcc_id() { return (unsigned)__builtin_amdgcn_s_getreg((3 << 11) | 20) & 0xFu; }
#define XB_SPIN(cond, bar) do { unsigned _sp = 0; while (cond) { __builtin_amdgcn_s_sleep(1); \
    if ((++_sp & 255u) == 0u) { if (xb_ld(&(bar)[XB_TMO])) break; if (_sp > XB_SPIN_CAP) { atomicAdd(&(bar)[XB_TMO], 1u); break; } } } } while (0)

struct XcdBarrier {
    unsigned* bar; unsigned x;
    volatile LAS unsigned* st;
};

__device__ __forceinline__ XcdBarrier xcd_barrier_post(unsigned* bar, volatile LAS unsigned* st) {
    XcdBarrier b; b.bar = bar; b.x = xb_xcc_id(); b.st = st;
    if (threadIdx.x == 0) (void)xb_add(&bar[XB_XCNT(b.x)], 1u);
    return b;
}
__device__ __forceinline__ void xcd_barrier_complete(unsigned* bar, unsigned x, unsigned& nloc, unsigned& nx) {
    const unsigned G = gridDim.x * gridDim.y * gridDim.z;
    unsigned sum, cnt, mine, sp = 0u;
    for (;;) {
        sum = 0u; cnt = 0u; mine = 0u;
#pragma unroll
        for (unsigned j = 0; j < 16; ++j) { const unsigned c = xb_ld(&bar[XB_XCNT(j)]); sum += c; cnt += (c > 0u) ? 1u : 0u; mine = (j == x) ? c : mine; }
        if (sum == G) break;
        __builtin_amdgcn_s_sleep(1);
        if ((++sp & 255u) == 0u) { if (xb_ld(&bar[XB_TMO])) break; if (sp > XB_SPIN_CAP) { atomicAdd(&bar[XB_TMO], 1u); break; } }
    }
    nloc = mine > 0u ? mine : 1u; nx = cnt > 0u ? cnt : 1u;
}

__device__ __forceinline__ void xcd_barrier(const XcdBarrier& b) {
    asm volatile("s_waitcnt vmcnt(0)" ::: "memory");
    __syncthreads();
    if (threadIdx.x == 0) {
        unsigned* bar = b.bar;
        __builtin_amdgcn_s_waitcnt(0);
        unsigned nloc = b.st[0], nx = b.st[1];
        if (nloc == 0u) { xcd_barrier_complete(bar, b.x, nloc, nx); b.st[0] = nloc; b.st[1] = nx; }
        const unsigned old = xb_add(&bar[XB_XSUB(b.x)], 1u);
        const unsigned gen = old / nloc;
        if (old + 1u == (gen + 1u) * nloc) {
            __builtin_amdgcn_fence(__ATOMIC_RELEASE, "agent");
            asm volatile("s_waitcnt vmcnt(0)" ::: "memory");
            const unsigned og = xb_add(&bar[XB_TOP], 1u);
            const unsigned tg = og / nx;
            if (og + 1u == (tg + 1u) * nx) xb_add(&bar[XB_TOPGEN], 1u);
            else XB_SPIN(xb_ld(&bar[XB_TOPGEN]) == tg, bar);
            __builtin_amdgcn_fence(__ATOMIC_ACQUIRE, "agent");
            xb_add(&bar[XB_XGEN(b.x)], 1u);
            asm volatile("s_waitcnt vmcnt(0)" ::: "memory");
        } else {
            XB_SPIN(xb_ld(&bar[XB_XGEN(b.x)]) == gen, bar);
            __builtin_amdgcn_fence(__ATOMIC_ACQUIRE, "agent");
            asm volatile("s_waitcnt vmcnt(0)" ::: "memory");
        }
    }
    __syncthreads();
}

typedef unsigned short bf16;
typedef short bf16x8 __attribute__((ext_vector_type(8)));
typedef float f32x4 __attribute__((ext_vector_type(4)));
typedef unsigned u32x4 __attribute__((ext_vector_type(4)));
typedef unsigned u32x2 __attribute__((ext_vector_type(2)));

constexpr int DM = 2048, TP = 16384, DEC_B = 32, DEC_S = 4, NSMP = DEC_B * DEC_S, MROWS = TP + NSMP, MPAD = 16640;
constexpr int NIN = 12800, DFF = 5632, NUP = 2 * DFF;
constexpr int C_ZQ = 0, C_ZF = 1024, C_ZI = 2048, C_ZG = 3072, C_AQ = 4096, C_AK = 5632, C_AV = 7168, C_GA = 8704, C_GB = 10752;
constexpr int NCHUNK = TP / 64;
constexpr float EPS = 1e-6f;
constexpr size_t O_Y = 0, O_YS = 33554432, O_HP = 33816576, O_HS = 33947648, O_KV0P = 38141952, O_KV0S = 38273024, O_KV1P = 42467328, O_KV1S = 42991616,
                 O_KV2P = 59768832, O_KV2S = 61865984, O_CVP = 128974848, O_CVS = 128997376, O_END = 129718272;
constexpr size_t MiB = 1u << 20;
constexpr size_t WS_WIN = 1 * MiB;
constexpr size_t WS_WPA = WS_WIN + (size_t)NIN * DM * 2;
constexpr size_t WS_WPB = WS_WPA + (size_t)DM * 1024 * 2;
constexpr size_t WS_WOUT = WS_WPB + (size_t)DM * 512 * 2;
constexpr size_t WS_WUP = WS_WOUT + (size_t)DM * DM * 2;
constexpr size_t WS_WDN = WS_WUP + (size_t)NUP * DM * 2;
constexpr size_t WS_XB = WS_WDN + (size_t)DM * DFF * 2;
constexpr size_t WS_R1 = WS_XB + (size_t)MPAD * DM * 2;
constexpr size_t WS_R2 = WS_R1 + (size_t)MPAD * 4;
constexpr size_t WS_LB = WS_R2 + (size_t)MPAD * 4;
constexpr size_t WS_Z = WS_LB + 4096;
constexpr size_t WS_G32 = WS_Z + (size_t)MPAD * NIN * 2;
constexpr size_t WS_HST = WS_G32 + (size_t)MPAD * 1024 * 4;
constexpr size_t WS_HD = WS_HST + (size_t)8 * NCHUNK * 16384 * 4;
constexpr size_t WS_OA = WS_HD + (size_t)8 * NCHUNK * 128 * 4;
constexpr size_t WS_OB = WS_OA + (size_t)MPAD * 1536 * 2;
constexpr size_t WS_OG = WS_OB + (size_t)MPAD * 512 * 2;
constexpr size_t WS_LSE = WS_OG + (size_t)3 * MPAD * 512 * 2;
constexpr size_t WS_Y1 = WS_LSE + (size_t)3 * MPAD * 4 * 4;
constexpr size_t WS_Y2 = WS_Y1 + (size_t)MPAD * DM * 2;
constexpr size_t WS_MIX = WS_Y2 + (size_t)MPAD * DM * 2;
constexpr size_t WS_C = WS_MIX + (size_t)MPAD * DM * 2;
constexpr size_t WS_U = WS_C + (size_t)MPAD * DM * 4;
constexpr size_t WS_ACT = WS_U + (size_t)MPAD * NUP * 2;
constexpr size_t WS_SSP1 = WS_ACT + (size_t)MPAD * DFF * 2;
constexpr size_t WS_SSP2 = WS_SSP1 + (size_t)MPAD * 32 * 4;
constexpr size_t WS_SLAB = WS_SSP2 + (size_t)MPAD * 32 * 4;
constexpr size_t WS_END = WS_SLAB + (size_t)16 * 128 * 2048 * 4;

__device__ __forceinline__ float bf2f(bf16 b) { return __uint_as_float(((unsigned)b) << 16); }
__device__ __forceinline__ unsigned pk2(float lo, float hi) { unsigned r; asm volatile("v_cvt_pk_bf16_f32 %0, %1, %2" : "=v"(r) : "v"(lo), "v"(hi)); return r; }
__device__ __forceinline__ unsigned f2bf(float f) { return pk2(f, f) & 0xffffu; }
__device__ __forceinline__ float wave_sum(float v, int lane) {
#pragma unroll
    for (int o = 1; o < 64; o <<= 1) v += shx(v, o, lane);
    return v;
}
__device__ __forceinline__ float bflo_(unsigned w) { return __uint_as_float(w << 16); }
__device__ __forceinline__ float bfhi_(unsigned w) { return __uint_as_float(w & 0xffff0000u); }
__device__ __forceinline__ float sigmoidf_(float z) { return 1.f / (1.f + expf(-z)); }
__device__ __forceinline__ int row_of_sample(int b, int s) { return TP + b * DEC_S + s; }

#define MFMA16(a, b, c) __builtin_amdgcn_mfma_f32_16x16x32_bf16((a), (b), (c), 0, 0, 0)
__device__ __forceinline__ bf16x8 ldfrag(const bf16* base, int ld, int r0, int k0, int lane) { return *(const bf16x8*)(base + (r0 + (lane & 15)) * ld + k0 + 8 * (lane >> 4)); }

template <bool REMAP_UP  >
__device__ __forceinline__ void p_wtrans(const float* __restrict__ W, int K, int N, bf16* __restrict__ WT, int ldo  , const float* __restrict__ ks, unsigned char* lds, int vcu, int G, int wv) {
    const int tfull = otid(wv);
    float (*tile)[65] = (float (*)[65])(lds + (tfull >> 8) * 16640);
    const int nbn = N / 64, ntile = (K / 64) * nbn, tid = tfull & 255;
    for (int base = 2 * vcu; base < ntile; base += 2 * G) {
        const int it = base + (tfull >> 8); const bool live = it < ntile;
        const int k0 = live ? (it / nbn) * 64 : 0, n0 = live ? (it % nbn) * 64 : 0;
        __syncthreads();
#pragma unroll 4
        for (int i = 0; i < 16; ++i) { const int kk = i * 4 + (tid >> 6), c = tid & 63; float v = W[(size_t)(k0 + kk) * N + n0 + c]; if (ks) v *= ks[k0 + kk]; tile[kk][c] = v; }
        __syncthreads();
        const int n = tid >> 2, kc = (tid & 3) * 16;
        if (live)
#pragma unroll
        for (int h = 0; h < 2; ++h) { u32x4 o; const int kb = kc + h * 8;
            o.x = pk2(tile[kb + 0][n], tile[kb + 1][n]); o.y = pk2(tile[kb + 2][n], tile[kb + 3][n]); o.z = pk2(tile[kb + 4][n], tile[kb + 5][n]); o.w = pk2(tile[kb + 6][n], tile[kb + 7][n]);
            int nn = n0 + n; if (REMAP_UP) nn = nn < DFF ? (nn >> 7) * 256 + (nn & 127) : ((nn - DFF) >> 7) * 256 + 128 + ((nn - DFF) & 127);
            *(u32x4*)(WT + (size_t)nn * ldo + k0 + kb) = o; }
    }
}
__device__ __forceinline__ void p_xprep(const float* __restrict__ xp, const float* __restrict__ xs, bf16* __restrict__ xb, float* __restrict__ r1, int vcu, int G, int wv) {
    const int tid_ = otid(wv), lane = tid_ & 63, gw = vcu * 8 + (tid_ >> 6), ngw = G * 8;
    for (int row = gw; row < MPAD; row += ngw) {
        u32x2* o = (u32x2*)(xb + (size_t)row * DM) + lane;
        if (row >= MROWS) {
#pragma unroll
            for (int j = 0; j < 8; ++j) o[64 * j] = (u32x2){0u, 0u};
            if (lane == 0) r1[row] = 1.f; continue; }
        const f32x4* src = (const f32x4*)(row < TP ? xp + (size_t)row * DM : xs + (size_t)(row - TP) * DM) + lane;
        f32x4 v[8]; float ss = 0.f;
#pragma unroll
        for (int j = 0; j < 8; ++j) { v[j] = src[64 * j]; ss += v[j].x * v[j].x + v[j].y * v[j].y + v[j].z * v[j].z + v[j].w * v[j].w; }
        ss = wave_sum(ss, lane);
#pragma unroll
        for (int j = 0; j < 8; ++j) o[64 * j] = (u32x2){pk2(v[j].x, v[j].y), pk2(v[j].z, v[j].w)};
        if (lane == 0) r1[row] = rsqrtf(ss * (1.f / DM) + EPS);
    }
}
__device__ __forceinline__ void p_lb(const float* __restrict__ lbl, float* __restrict__ lbv, int vcu, int G, int wv) { const int i = vcu * 512 + otid(wv); if (i < 1024) lbv[i] = 1.f / (1.f + expf(lbl[1024 + i] - lbl[i])); }

__device__ __forceinline__ void p_act_in(bf16* __restrict__ Z, const float* __restrict__ r1, const float* __restrict__ lbv, float* __restrict__ g32, int vcu, int G, int wv) {
    const size_t nchunk = (size_t)MROWS * (NIN / 8);
    for (size_t i = (size_t)vcu * 512 + otid(wv); i < nchunk; i += (size_t)G * 512) {
        const int row = (int)(i / (NIN / 8)), c0 = (int)(i % (NIN / 8)) * 8;
        u32x4* p = (u32x4*)(Z + (size_t)row * NIN + c0); const u32x4 w = *p; const float r = r1[row];
        float z[8]; z[0] = __uint_as_float(w.x << 16); z[1] = __uint_as_float(w.x & 0xffff0000u); z[2] = __uint_as_float(w.y << 16); z[3] = __uint_as_float(w.y & 0xffff0000u);
        z[4] = __uint_as_float(w.z << 16); z[5] = __uint_as_float(w.z & 0xffff0000u); z[6] = __uint_as_float(w.w << 16); z[7] = __uint_as_float(w.w & 0xffff0000u);
#pragma unroll
        for (int j = 0; j < 8; ++j) z[j] *= r;
        if (c0 < C_ZF || (c0 >= C_ZG && c0 < C_AQ)) {
#pragma unroll
            for (int j = 0; j < 8; ++j) z[j] = z[j] * sigmoidf_(z[j]);
        } else if (c0 < C_ZI) {
            float gl[8];
#pragma unroll
            for (int j = 0; j < 8; ++j) { const float lb = lbv[c0 - C_ZF + j]; const float f = lb + (1.f - lb) * sigmoidf_(z[j]); gl[j] = logf(f); z[j] = 1.f - f; }
            f32x4* gp = (f32x4*)(g32 + (size_t)row * 1024 + (c0 - C_ZF)); gp[0] = (f32x4){gl[0], gl[1], gl[2], gl[3]}; gp[1] = (f32x4){gl[4], gl[5], gl[6], gl[7]};
        } else if (c0 >= C_GA) {
#pragma unroll
            for (int j = 0; j < 8; ++j) z[j] = sigmoidf_(z[j]);
        }
        u32x4 o; o.x = pk2(z[0], z[1]); o.y = pk2(z[2], z[3]); o.z = pk2(z[4], z[5]); o.w = pk2(z[6], z[7]); *p = o;
    }
}


constexpr int KVC_N0 = DEC_B * (128 - DEC_S) * 256, KVC_N1 = DEC_B * (512 - DEC_S) * 256, KVC_N2 = DEC_B * (2048 - DEC_S) * 256, KVC_NTOT = KVC_N0 + KVC_N1 + KVC_N2;
__device__ __forceinline__ bool kvc_addr(int i, const float* c0, const float* c1, const float* c2, float* out, const f32x4*& src, f32x4*& dst) {
    if (i >= KVC_NTOT) return false;
    const float* cache; float* os; int L;
    if (i < KVC_N0) { cache = c0; os = out + O_KV0S; L = 128; } else if ((i -= KVC_N0) < KVC_N1) { cache = c1; os = out + O_KV1S; L = 512; } else { i -= KVC_N1; cache = c2; os = out + O_KV2S; L = 2048; }
    const int per_b = (L - DEC_S) * 256, b = i / per_b, e = i - b * per_b;
    src = (const f32x4*)(cache + (size_t)b * L * 1024 + (size_t)DEC_S * 1024) + e; dst = (f32x4*)(os + (size_t)b * L * 1024) + e; return true;
}
struct KvIter {
    const f32x4* src; f32x4* dst; int i, e, per_b; bool ok;
    __device__ __forceinline__ void decode(const float* c0, const float* c1, const float* c2, float* out) {
        ok = i < KVC_NTOT; int j = i; const float* cache = c0; float* os = out + O_KV0S; int L = 128;
        if (j >= KVC_N0) { j -= KVC_N0; cache = c1; os = out + O_KV1S; L = 512; if (j >= KVC_N1) { j -= KVC_N1; cache = c2; os = out + O_KV2S; L = 2048; } }
        per_b = (L - DEC_S) * 256; const int b = ok ? j / per_b : 0; e = ok ? j - b * per_b : 0;
        src = (const f32x4*)(cache + (size_t)b * L * 1024 + (size_t)DEC_S * 1024) + e; dst = (f32x4*)(os + (size_t)b * L * 1024) + e;
    }
    __device__ __forceinline__ void start(int i0, const float* c0, const float* c1, const float* c2, float* out) { i = i0; decode(c0, c1, c2, out); }
    __device__ __forceinline__ void next(const float* c0, const float* c1, const float* c2, float* out) { i += 512; e += 512; src += 512; dst += 512; if (e >= per_b || i >= KVC_NTOT) decode(c0, c1, c2, out); }
};
template <int NPT> struct KvCopy {
    f32x4 v[NPT];
    __device__ __forceinline__ void issue(int first, int tid, const float* c0, const float* c1, const float* c2, float* out) {
        KvIter it; it.start(first + tid, c0, c1, c2, out);
#pragma unroll
        for (int q = 0; q < NPT; ++q) { if (it.ok) v[q] = __builtin_nontemporal_load(it.src); it.next(c0, c1, c2, out); }
    }
    __device__ __forceinline__ void commit(int first, int tid, const float* c0, const float* c1, const float* c2, float* out) {
        KvIter it; it.start(first + tid, c0, c1, c2, out);
#pragma unroll
        for (int q = 0; q < NPT; ++q) { if (it.ok) __builtin_nontemporal_store(v[q], it.dst); it.next(c0, c1, c2, out); }
    }
};
constexpr int KVC_LOCAL_NPT = 16, KVC_OUT_NPT = 8, KVC_OUT_BASE = 8 * NCHUNK * 512 * KVC_LOCAL_NPT;
static_assert(KVC_OUT_BASE + 8 * NCHUNK * 512 * KVC_OUT_NPT >= KVC_NTOT, "the carried KV copy covers every piece");
__device__ __forceinline__ void p_hgrn_local(const bf16* __restrict__ Z, const float* __restrict__ g32, bf16* __restrict__ HSTB, float* __restrict__ HD, const float* kc0, const float* kc1, const float* kc2, float* out, unsigned char* lds, int vcu, int G, int wv) {
    bf16* KxT = (bf16*)lds;
    bf16* VT = KxT + 128 * 72;
    float (*tot)[128] = (float (*)[128])(VT + 128 * 72);
    float* scl = (float*)tot + 512;
    const int tid = otid(wv), lane = tid & 63, w = tid >> 6;
    const int k = tid & 127, part = tid >> 7;
    float gl[16]; unsigned short kr[16]; u32x4 va, vc;
#define HL_LOAD(item_) do { const int h_ = (item_) / NCHUNK, n_ = (item_) % NCHUNK, row0_ = n_ * 64 + part * 16; \
        _Pragma("unroll") for (int i = 0; i < 16; ++i) { gl[i] = g32[(size_t)(row0_ + i) * 1024 + h_ * 128 + k]; kr[i] = Z[(size_t)(row0_ + i) * NIN + C_ZF + h_ * 128 + k]; } \
        const bf16* vp_ = Z + (size_t)(n_ * 64 + (tid >> 3)) * NIN + C_ZI + h_ * 128 + (tid & 7) * 16; va = *(const u32x4*)vp_; vc = *(const u32x4*)(vp_ + 8); } while (0)
    if (vcu < 8 * NCHUNK) HL_LOAD(vcu);
    for (int item = vcu; item < 8 * NCHUNK; item += G) {
        KvCopy<KVC_LOCAL_NPT> cp; cp.issue(item * 512 * KVC_LOCAL_NPT, tid, kc0, kc1, kc2, out);
        __syncthreads();
        float b[16]; { float c = 0.f;
#pragma unroll
            for (int i = 0; i < 16; ++i) { c += gl[i]; b[i] = c; }
            tot[part][k] = c; }
        {
            const int t = tid >> 3, dv0 = (tid & 7) * 16; const unsigned ww[8] = {va.x, va.y, va.z, va.w, vc.x, vc.y, vc.z, vc.w};
#pragma unroll
            for (int j = 0; j < 8; ++j) { VT[(dv0 + 2 * j) * 72 + t] = (bf16)(ww[j] & 0xffffu); VT[(dv0 + 2 * j + 1) * 72 + t] = (bf16)(ww[j] >> 16); }
        }
        __syncthreads();
        float off = 0.f;
#pragma unroll
        for (int p = 0; p < 4; ++p) if (p < part) off += tot[p][k];
        const float R = tot[0][k] + tot[1][k], b63 = R + tot[2][k] + tot[3][k];
        unsigned pk[8];
#pragma unroll
        for (int i = 0; i < 16; i += 2) pk[i >> 1] = pk2(bf2f(kr[i]) * __expf(fminf(R - (off + b[i]), 80.f)), bf2f(kr[i + 1]) * __expf(fminf(R - (off + b[i + 1]), 80.f)));
        u32x4* dst = (u32x4*)(KxT + k * 72 + part * 16); dst[0] = (u32x4){pk[0], pk[1], pk[2], pk[3]}; dst[1] = (u32x4){pk[4], pk[5], pk[6], pk[7]};
        if (part == 0) { scl[k] = __expf(b63 - R); HD[(size_t)item * 128 + k] = __expf(b63); }
        __syncthreads();
        if (item + G < 8 * NCHUNK) HL_LOAD(item + G);
        f32x4 acc[8];
#pragma unroll
        for (int kt = 0; kt < 8; ++kt) acc[kt] = (f32x4){0.f, 0.f, 0.f, 0.f};
#pragma unroll
        for (int ks = 0; ks < 2; ++ks) { const bf16x8 a = ldfrag(VT, 72, 16 * w, 32 * ks, lane);
#pragma unroll
            for (int kt = 0; kt < 8; ++kt) { const bf16x8 bb = ldfrag(KxT, 72, 16 * kt, 32 * ks, lane); acc[kt] = MFMA16(bb, a, acc[kt]); } }
        bf16* dstS = HSTB + (size_t)item * 16384 + (16 * w + (lane & 15)) * 128 + 4 * (lane >> 4);
#pragma unroll
        for (int kt = 0; kt < 8; ++kt) { const f32x4 s = *(const f32x4*)(scl + 16 * kt + 4 * (lane >> 4));
            *(u32x2*)(dstS + 16 * kt) = (u32x2){pk2(acc[kt][0] * s[0], acc[kt][1] * s[1]), pk2(acc[kt][2] * s[2], acc[kt][3] * s[3])}; }
        cp.commit(item * 512 * KVC_LOCAL_NPT, tid, kc0, kc1, kc2, out);
    }
#undef HL_LOAD
}
__device__ __forceinline__ void p_hgrn_scan(bf16* __restrict__ HSTB, const float* __restrict__ HD, float* __restrict__ out_hp, int vcu, int G, int wv) {
  if (wv < 4) for (int idx = vcu * 256 + otid(wv); idx < 8 * 8192; idx += G * 256) {
    const int h = idx >> 13, rem = (idx & 8191) * 2, k = rem & 127, dv = rem >> 7;
    float S0 = 0.f, S1 = 0.f;
    unsigned u[16], un[16]; float2 d[16], dn[16];
#pragma unroll
    for (int j = 0; j < 16; ++j) { u[j] = *(const unsigned*)(HSTB + ((size_t)(h * NCHUNK + j) << 14) + rem); d[j] = *(const float2*)(HD + (size_t)(h * NCHUNK + j) * 128 + k); }
    for (int n0 = 0; n0 < NCHUNK; n0 += 16) {
        if (n0 + 16 < NCHUNK) {
#pragma unroll
            for (int j = 0; j < 16; ++j) { un[j] = *(const unsigned*)(HSTB + ((size_t)(h * NCHUNK + n0 + 16 + j) << 14) + rem); dn[j] = *(const float2*)(HD + (size_t)(h * NCHUNK + n0 + 16 + j) * 128 + k); } }
#pragma unroll
        for (int j = 0; j < 16; ++j) { *(unsigned*)(HSTB + ((size_t)(h * NCHUNK + n0 + j) << 14) + rem) = pk2(S0, S1); S0 = d[j].x * S0 + bflo_(u[j]); S1 = d[j].y * S1 + bfhi_(u[j]); }
#pragma unroll
        for (int j = 0; j < 16; ++j) { u[j] = un[j]; d[j] = dn[j]; }
    }
    out_hp[h * 16384 + k * 128 + dv] = S0; out_hp[h * 16384 + (k + 1) * 128 + dv] = S1;
  }
}
template <bool SAMPLE>
__device__ __forceinline__ void p_hgrn_out(const bf16* __restrict__ Z, const float* __restrict__ g32, const bf16* __restrict__ HSTB, const float* __restrict__ S0in,
                                           const float* __restrict__ nw, bf16* __restrict__ OA, float* __restrict__ out_hs, const float* kc0, const float* kc1, const float* kc2, float* outp, unsigned char* smem, int vcu, int G, int wv) {
    bf16* Acat = (bf16*)smem;
    bf16* Kx = Acat + 64 * 200;
    bf16* Bcat = Kx + 64 * 136;
    float* osh = (float*)(Bcat + 128 * 200);
    float* tot = osh + 64 * 132;
    float* eR = tot + 512;
    float* wk = eR + 128;
    float* vv = wk + 512;
    float* nwl = vv + 512;
    const int tid = otid(wv), lane = tid & 63, w = tid >> 6;
    __syncthreads();
    nwl[tid] = nw[tid]; nwl[512 + tid] = nw[512 + tid];
    const int nitem = SAMPLE ? DEC_B * 8 : 8 * NCHUNK;
    float pg[16]; unsigned short pq[16], pkk[16]; u32x4 pva, pvc, pz0, pz1;
#define HO_LOAD(item_) do { const int h_ = (item_) / NCHUNK, n_ = (item_) % NCHUNK, r0_ = n_ * 64 + (tid >> 7) * 16, kq_ = h_ * 128 + (tid & 127); \
        _Pragma("unroll") for (int i = 0; i < 16; ++i) { pg[i] = g32[(size_t)(r0_ + i) * 1024 + kq_]; pq[i] = Z[(size_t)(r0_ + i) * NIN + C_ZQ + kq_]; pkk[i] = Z[(size_t)(r0_ + i) * NIN + C_ZF + kq_]; } \
        const bf16* zp_ = Z + (size_t)(n_ * 64 + (tid >> 3)) * NIN + h_ * 128 + (tid & 7) * 16; pva = *(const u32x4*)(zp_ + C_ZI); pvc = *(const u32x4*)(zp_ + C_ZI + 8); pz0 = *(const u32x4*)(zp_ + C_ZG); pz1 = *(const u32x4*)(zp_ + C_ZG + 8); } while (0)
    if (!SAMPLE && vcu < nitem) HO_LOAD(vcu);
    for (int item = vcu; item < nitem; item += G) {
        const int h = SAMPLE ? (item & 7) : item / NCHUNK, n = SAMPLE ? (item >> 3) : item % NCHUNK;
        __syncthreads();
        const int k = tid & 127, part = tid >> 7;
        float b[16], gq[16], gk[16];
        if (!SAMPLE) { float c = 0.f;
#pragma unroll
            for (int i = 0; i < 16; ++i) { c += pg[i]; b[i] = c; gq[i] = bf2f(pq[i]); gk[i] = bf2f(pkk[i]); }
            tot[part * 128 + k] = c;
        } else { float c = 0.f; float g4[4]; unsigned short q4[4], k4[4];
#pragma unroll
            for (int i = 0; i < 4; ++i) { const int row = row_of_sample(n, i); g4[i] = g32[(size_t)row * 1024 + h * 128 + k]; q4[i] = Z[(size_t)row * NIN + C_ZQ + h * 128 + k]; k4[i] = Z[(size_t)row * NIN + C_ZF + h * 128 + k]; }
#pragma unroll
            for (int i = 0; i < 16; ++i) { const bool ok = part == 0 && i < DEC_S;
                const float g = ok ? g4[i & 3] : 0.f; c += g; b[i] = c; gq[i] = ok ? bf2f(q4[i & 3]) : 0.f; gk[i] = ok ? bf2f(k4[i & 3]) : 0.f; }
            tot[part * 128 + k] = c; }
        f32x4 sreg[8]; u32x4 zg0, zg1;
        if (!SAMPLE) { const u32x4* sp = (const u32x4*)(HSTB + (size_t)item * 16384 + (tid >> 2) * 128 + (tid & 3) * 32);
#pragma unroll
            for (int q = 0; q < 4; ++q) { const u32x4 w_ = sp[q]; sreg[2 * q] = (f32x4){bflo_(w_.x), bfhi_(w_.x), bflo_(w_.y), bfhi_(w_.y)}; sreg[2 * q + 1] = (f32x4){bflo_(w_.z), bfhi_(w_.z), bflo_(w_.w), bfhi_(w_.w)}; }
        } else { const float* sp = S0in + ((size_t)(n * 8 + h) * 128 + (tid >> 2)) * 128 + (tid & 3) * 32;
#pragma unroll
            for (int q = 0; q < 8; ++q) sreg[q] = *(const f32x4*)(sp + 4 * q); }
        { const int t = tid >> 3, pc = (tid & 7) * 16; const bool ok = !SAMPLE || t < DEC_S; const int row = SAMPLE ? row_of_sample(n, t & 3) : n * 64 + t;
            zg0 = (u32x4){0u, 0u, 0u, 0u}; zg1 = zg0; if (!SAMPLE) { zg0 = pz0; zg1 = pz1; } else if (ok) { const bf16* gp = Z + (size_t)row * NIN + C_ZG + h * 128 + pc; zg0 = *(const u32x4*)gp; zg1 = *(const u32x4*)(gp + 8); } }
        KvCopy<KVC_OUT_NPT> cp; if (!SAMPLE) cp.issue(KVC_OUT_BASE + item * 512 * KVC_OUT_NPT, tid, kc0, kc1, kc2, outp);
        {
            const int t = tid >> 3, dv0 = (tid & 7) * 16; const bool ok = !SAMPLE || t < DEC_S; const int row = SAMPLE ? row_of_sample(n, t & 3) : n * 64 + t;
            const bf16* vp = Z + (size_t)row * NIN + C_ZI + h * 128 + dv0; u32x4 a = (u32x4){0u, 0u, 0u, 0u}, c = a; if (!SAMPLE) { a = pva; c = pvc; } else if (ok) { a = *(const u32x4*)vp; c = *(const u32x4*)(vp + 8); }
            const unsigned ww[8] = {a.x, a.y, a.z, a.w, c.x, c.y, c.z, c.w};
#pragma unroll
            for (int j = 0; j < 8; ++j) { Bcat[(dv0 + 2 * j) * 200 + 128 + t] = (bf16)(ww[j] & 0xffffu); Bcat[(dv0 + 2 * j + 1) * 200 + 128 + t] = (bf16)(ww[j] >> 16);
                if (SAMPLE && t < DEC_S) { vv[t * 128 + dv0 + 2 * j] = bf2f((bf16)(ww[j] & 0xffffu)); vv[t * 128 + dv0 + 2 * j + 1] = bf2f((bf16)(ww[j] >> 16)); } }
        }
        __syncthreads();
        float off = 0.f;
#pragma unroll
        for (int p = 0; p < 4; ++p) if (p < part) off += tot[p * 128 + k];
        const float R = tot[k] + tot[128 + k], b63 = R + tot[256 + k] + tot[384 + k];
#pragma unroll
        for (int i = 0; i < 16; ++i) { const int t = part * 16 + i; const float bt = off + b[i];
            Acat[t * 200 + k] = (bf16)f2bf(gq[i] * __expf(fminf(bt - R, 80.f))); Kx[t * 136 + k] = (bf16)f2bf(gk[i] * __expf(fminf(R - bt, 80.f)));
            if (SAMPLE && t < DEC_S) wk[t * 128 + k] = gk[i] * expf(b63 - bt); }
        if (part == 0) eR[k] = expf(R);
        __syncthreads();
        if (!SAMPLE && item + G < nitem) HO_LOAD(item + G);
        if (!SAMPLE) { const int dv = tid >> 2, kc = (tid & 3) * 32;
#pragma unroll
            for (int q = 0; q < 4; ++q) { const f32x4 s0 = sreg[2 * q], s1 = sreg[2 * q + 1]; const float* e = eR + kc + 8 * q;
                u32x4 o; o.x = pk2(s0.x * e[0], s0.y * e[1]); o.y = pk2(s0.z * e[2], s0.w * e[3]); o.z = pk2(s1.x * e[4], s1.y * e[5]); o.w = pk2(s1.z * e[6], s1.w * e[7]);
                *(u32x4*)(Bcat + dv * 200 + kc + 8 * q) = o; }
        } else {
            const int kk = tid >> 2, dc = (tid & 3) * 32; const float e = eR[kk];
#pragma unroll
            for (int q = 0; q < 8; ++q) { const f32x4 s = sreg[q];
                Bcat[(dc + 4 * q + 0) * 200 + kk] = (bf16)f2bf(s.x * e); Bcat[(dc + 4 * q + 1) * 200 + kk] = (bf16)f2bf(s.y * e);
                Bcat[(dc + 4 * q + 2) * 200 + kk] = (bf16)f2bf(s.z * e); Bcat[(dc + 4 * q + 3) * 200 + kk] = (bf16)f2bf(s.w * e); }
        }
        { const int tt = w >> 1;
#pragma unroll
            for (int sj = 0; sj < 2; ++sj) { const int st = 2 * (w & 1) + sj; f32x4 acc = (f32x4){0.f, 0.f, 0.f, 0.f};
                if (st <= tt) {
#pragma unroll
                    for (int ks = 0; ks < 4; ++ks) acc = MFMA16(ldfrag(Acat, 200, 16 * tt, 32 * ks, lane), ldfrag(Kx, 136, 16 * st, 32 * ks, lane), acc); }
                const int s = 16 * st + (lane & 15);
#pragma unroll
                for (int r = 0; r < 4; ++r) { const int t = 16 * tt + 4 * (lane >> 4) + r; Acat[t * 200 + 128 + s] = (bf16)f2bf(s <= t ? acc[r] : 0.f); } } }
        __syncthreads();
        { const int tt = w & 3, d0 = 4 * (w >> 2); f32x4 acc[4];
#pragma unroll
            for (int j = 0; j < 4; ++j) acc[j] = (f32x4){0.f, 0.f, 0.f, 0.f};
#pragma unroll
            for (int ks = 0; ks < 6; ++ks) { const bf16x8 a = ldfrag(Acat, 200, 16 * tt, 32 * ks, lane);
#pragma unroll
                for (int j = 0; j < 4; ++j) acc[j] = MFMA16(a, ldfrag(Bcat, 200, 16 * (d0 + j), 32 * ks, lane), acc[j]); }
#pragma unroll
            for (int j = 0; j < 4; ++j)
#pragma unroll
                for (int r = 0; r < 4; ++r) osh[(16 * tt + 4 * (lane >> 4) + r) * 132 + 16 * (d0 + j) + (lane & 15)] = acc[j][r]; }
        __syncthreads();
        { const int t = tid >> 3, pc = (tid & 7) * 16; const bool ok = !SAMPLE || t < DEC_S; const int row = SAMPLE ? row_of_sample(n, t & 3) : n * 64 + t;
            float o[16], ss = 0.f;
#pragma unroll
            for (int j = 0; j < 16; ++j) { o[j] = osh[t * 132 + pc + j]; ss += o[j] * o[j]; }
            ss += shx(ss, 1, lane); ss += shx(ss, 2, lane); ss += shx(ss, 4, lane);
            const float rs = rsqrtf(ss * (1.f / 128.f) + EPS);
            if (ok) { const unsigned gw[8] = {zg0.x, zg0.y, zg0.z, zg0.w, zg1.x, zg1.y, zg1.z, zg1.w};
                unsigned ow[8];
#pragma unroll
                for (int j = 0; j < 8; ++j) { const float a0 = o[2 * j] * rs * nwl[h * 128 + pc + 2 * j] * __uint_as_float(gw[j] << 16), a1 = o[2 * j + 1] * rs * nwl[h * 128 + pc + 2 * j + 1] * __uint_as_float(gw[j] & 0xffff0000u); ow[j] = pk2(a0, a1); }
                u32x4* op = (u32x4*)(OA + (size_t)row * 1536 + h * 128 + pc); op[0] = (u32x4){ow[0], ow[1], ow[2], ow[3]}; op[1] = (u32x4){ow[4], ow[5], ow[6], ow[7]}; }
        }
        if (!SAMPLE) cp.commit(KVC_OUT_BASE + item * 512 * KVC_OUT_NPT, tid, kc0, kc1, kc2, outp);
        if (SAMPLE) {
            const int kk = tid >> 2, dc = (tid & 3) * 32; const size_t so = ((size_t)(n * 8 + h) * 128 + kk) * 128 + dc;
            const float dk = expf(tot[kk] + tot[128 + kk] + tot[256 + kk] + tot[384 + kk]);
            const float w0 = wk[kk], w1 = wk[128 + kk], w2 = wk[256 + kk], w3 = wk[384 + kk];
#pragma unroll
            for (int q = 0; q < 8; ++q) { const f32x4 s = sreg[q]; f32x4 o;
#pragma unroll
                for (int e = 0; e < 4; ++e) { const int dv = dc + 4 * q + e; o[e] = dk * s[e] + w0 * vv[dv] + w1 * vv[128 + dv] + w2 * vv[256 + dv] + w3 * vv[384 + dv]; }
                *(f32x4*)(out_hs + so + 4 * q) = o; }
        }
    }
}
#undef HO_LOAD
constexpr int HGRN_OUT_LDS = (64 * 200 + 64 * 136 + 128 * 200) * 2 + (64 * 132 + 512 + 128 + 512 + 512) * 4;

__device__ __forceinline__ float alibi_slope(int g, int h) { return exp2f(-8.f * (float)(g * 4 + h + 1) / 12.f); }
__device__ __forceinline__ void p_attn_prompt(const bf16* __restrict__ Z, bf16* __restrict__ OG, float* __restrict__ LSE, unsigned char* smem, int vcu, int G, int wv) {
    bf16* Ksh = (bf16*)smem;
    bf16* VT = Ksh + 256 * 136;
    const int tid = otid(wv), lane = tid & 63, w = tid >> 6;
    u32x4 pkx[8], pvx[8];
#define AT_LOAD(item_) do { const int gh_ = (item_) >> 7, g_ = gh_ >> 2, h_ = gh_ & 3, wi_ = (item_) & 127, dil_ = g_ == 0 ? 1 : (g_ == 1 ? 4 : 16), nqb_ = 128 / dil_, r_ = wi_ / nqb_, m0_ = (wi_ % nqb_) * 128; \
        const int t_ = otid(wv); const int m_ = m0_ - 128 + (t_ >> 1); const bool ok_ = m_ >= 0; const size_t row_ = ok_ ? (size_t)m_ * dil_ + r_ : 0; \
        const u32x4* kp_ = (const u32x4*)(Z + row_ * NIN + C_AK + g_ * 512 + h_ * 128 + (t_ & 1) * 64); const u32x4* vp_ = (const u32x4*)(Z + row_ * NIN + C_AV + g_ * 512 + h_ * 128 + (t_ & 1) * 64); \
        _Pragma("unroll") for (int j = 0; j < 8; ++j) { pkx[j] = (u32x4){0u, 0u, 0u, 0u}; pvx[j] = pkx[j]; if (ok_) { pkx[j] = kp_[j]; pvx[j] = vp_[j]; } } } while (0)
    if (vcu < 12 * 128) AT_LOAD(vcu);
    for (int item = vcu; item < 12 * 128; item += G) {
        const int gh = item >> 7, g = gh >> 2, h = gh & 3, within = item & 127;
        const int dil = g == 0 ? 1 : (g == 1 ? 4 : 16), nqb = 128 / dil, r = within / nqb, qb = within % nqb, m0 = qb * 128;
        const int i0 = 16 * w, jstart = 32 * (w >> 1);
        const size_t qrow = (size_t)(m0 + i0 + (lane & 15)) * dil + r;
        bf16x8 qf[4];
#pragma unroll
        for (int ks = 0; ks < 4; ++ks) qf[ks] = *(const bf16x8*)(Z + qrow * NIN + C_AQ + g * 512 + h * 128 + 32 * ks + 8 * (lane >> 4));
        __syncthreads();
        {
            const int key = tid >> 1, half = tid & 1;
#pragma unroll
            for (int j = 0; j < 8; ++j) { *(u32x4*)(Ksh + key * 136 + half * 64 + 8 * j) = pkx[j]; const unsigned ww[4] = {pvx[j].x, pvx[j].y, pvx[j].z, pvx[j].w};
#pragma unroll
                for (int e = 0; e < 4; ++e) { const int d = half * 64 + 8 * j + 2 * e; VT[d * 264 + key] = (bf16)(ww[e] & 0xffffu); VT[(d + 1) * 264 + key] = (bf16)(ww[e] >> 16); } }
        }
        if (item + G < 12 * 128) AT_LOAD(item + G);
        __syncthreads();
        f32x4 sacc[10];
#pragma unroll
        for (int jt = 0; jt < 10; ++jt) { sacc[jt] = (f32x4){0.f, 0.f, 0.f, 0.f};
#pragma unroll
            for (int ks = 0; ks < 4; ++ks) sacc[jt] = MFMA16(ldfrag(Ksh, 136, jstart + 16 * jt, 32 * ks, lane), qf[ks], sacc[jt]); }
        const float slope = alibi_slope(g, h) * (float)dil; const int iq = i0 + (lane & 15);
        float mx = -3.0e38f;
#pragma unroll
        for (int jt = 0; jt < 10; ++jt)
#pragma unroll
            for (int rr = 0; rr < 4; ++rr) { const int j = jstart + 16 * jt + 4 * (lane >> 4) + rr, delta = 128 + iq - j; const bool valid = delta >= 0 && delta <= 128 && (m0 - 128 + j) >= 0;
                const float s = valid ? sacc[jt][rr] * 0.08838834764831845f - slope * (float)delta : -3.0e38f; sacc[jt][rr] = s; mx = fmaxf(mx, s); }
        mx = fmaxf(mx, shx(mx, 16, lane)); mx = fmaxf(mx, shx(mx, 32, lane));
        float den = 0.f;
#pragma unroll
        for (int jt = 0; jt < 10; ++jt)
#pragma unroll
            for (int rr = 0; rr < 4; ++rr) { const float p = sacc[jt][rr] > -1.0e38f ? expf(sacc[jt][rr] - mx) : 0.f; sacc[jt][rr] = p; den += p; }
        den += shx(den, 16, lane); den += shx(den, 32, lane);
        f32x4 oacc[8];
#pragma unroll
        for (int dt = 0; dt < 8; ++dt) oacc[dt] = (f32x4){0.f, 0.f, 0.f, 0.f};
#pragma unroll
        for (int ks = 0; ks < 5; ++ks) {
            u32x4 pw; pw.x = pk2(sacc[2 * ks][0], sacc[2 * ks][1]); pw.y = pk2(sacc[2 * ks][2], sacc[2 * ks][3]); pw.z = pk2(sacc[2 * ks + 1][0], sacc[2 * ks + 1][1]); pw.w = pk2(sacc[2 * ks + 1][2], sacc[2 * ks + 1][3]);
            const bf16x8 pf = __builtin_bit_cast(bf16x8, pw);
#pragma unroll
            for (int dt = 0; dt < 8; ++dt) { const bf16* vb = VT + (16 * dt + (lane & 15)) * 264 + jstart + 32 * ks + 4 * (lane >> 4);
                const u32x2 lo = *(const u32x2*)vb, hi = *(const u32x2*)(vb + 16); const u32x4 vw = (u32x4){lo.x, lo.y, hi.x, hi.y};
                oacc[dt] = MFMA16(pf, __builtin_bit_cast(bf16x8, vw), oacc[dt]); } }
        float inv[4];
#pragma unroll
        for (int rr = 0; rr < 4; ++rr) inv[rr] = 1.f / shl(den, 4 * (lane >> 4) + rr);
#pragma unroll
        for (int rr = 0; rr < 4; ++rr) { const size_t orow = (size_t)(m0 + i0 + 4 * (lane >> 4) + rr) * dil + r; bf16* op = OG + ((size_t)g * MPAD + orow) * 512 + h * 128 + (lane & 15);
#pragma unroll
            for (int dt = 0; dt < 8; ++dt) op[16 * dt] = (bf16)f2bf(oacc[dt][rr] * inv[rr]); }
        if (lane < 16) LSE[((size_t)g * MPAD + qrow) * 4 + h] = mx + logf(den);
    }
}
#undef AT_LOAD
constexpr int ATTN_LDS = (256 * 136 + 128 * 264) * 2;

__device__ __forceinline__ void p_attn_sample(const bf16* __restrict__ Z, const float* __restrict__ c0, const float* __restrict__ c1, const float* __restrict__ c2, bf16* __restrict__ OG, float* __restrict__ LSE, int vcu, int G, int wv) {
    const int tid_ = otid(wv), lane = tid_ & 63, gw = (tid_ >> 6) * G + vcu, ngw = G * 8;
    for (int it = gw; it < DEC_B * DEC_S * 12; it += ngw) {
        const int h = it & 3, g = (it >> 2) % 3, bs = it / 12, b = bs >> 2, s = bs & 3;
        const int dil = g == 0 ? 1 : (g == 1 ? 4 : 16), L = 128 * dil; const float* cache = g == 0 ? c0 : (g == 1 ? c1 : c2);
        const int row = row_of_sample(b, s), n_new = dil == 1 ? s + 1 : 1;
        const float slope = alibi_slope(g, h) * (float)dil;
        const unsigned qw = *(const unsigned*)(Z + (size_t)row * NIN + C_AQ + g * 512 + h * 128 + 2 * lane);
        const float q0 = bflo_(qw) * 0.08838834764831845f, q1 = bfhi_(qw) * 0.08838834764831845f;
        const float* kb = cache + (size_t)b * L * 1024 + h * 128 + 2 * lane;
        float s0v = -3.0e38f, s1v = -3.0e38f, s2v = -3.0e38f;
        float2 kk[8], kn[8];
#define AS_LOAD(dst, jb_, off_) do { _Pragma("unroll") for (int q = 0; q < 8; ++q) { int idx = L + s - ((jb_) + q) * dil; idx = idx < L ? idx : L - 1; dst[q] = *(const float2*)(kb + (size_t)idx * 1024 + (off_)); } } while (0)
        AS_LOAD(kk, 0, 0);
        for (int jb = 0; jb < 128; jb += 8) {
            if (jb + 8 < 128) AS_LOAD(kn, jb + 8, 0);
#pragma unroll
            for (int q = 0; q < 8; ++q) { const int j = jb + q; const float d = wave_sum(q0 * kk[q].x + q1 * kk[q].y, lane) - slope * (float)j; if ((j & 63) == lane) { if (jb < 64) s0v = d; else s1v = d; } }
#pragma unroll
            for (int q = 0; q < 8; ++q) kk[q] = kn[q]; }
        { const float2 kv = *(const float2*)(kb + (size_t)(L + s - 128 * dil) * 1024); const float d = wave_sum(q0 * kv.x + q1 * kv.y, lane) - slope * 128.f; if (lane == 0) s2v = d; }
        for (int j = 0; j < n_new; ++j) { const unsigned kw = *(const unsigned*)(Z + (size_t)row_of_sample(b, s - j * dil) * NIN + C_AK + g * 512 + h * 128 + 2 * lane);
            const float d = wave_sum(q0 * bflo_(kw) + q1 * bfhi_(kw), lane) - slope * (float)j; if (lane == j) s0v = d; }
        float mx = fmaxf(fmaxf(s0v, s1v), s2v);
#pragma unroll
        for (int o = 1; o < 64; o <<= 1) mx = fmaxf(mx, shx(mx, o, lane));
        const float p0 = s0v > -1.0e38f ? expf(s0v - mx) : 0.f, p1 = s1v > -1.0e38f ? expf(s1v - mx) : 0.f, p2 = s2v > -1.0e38f ? expf(s2v - mx) : 0.f;
        const float den = wave_sum(p0 + p1 + p2, lane);
        float o0 = 0.f, o1 = 0.f;
        AS_LOAD(kk, 0, 512);
        for (int jb = 0; jb < 128; jb += 8) {
            if (jb + 8 < 128) AS_LOAD(kn, jb + 8, 512);
#pragma unroll
            for (int q = 0; q < 8; ++q) { const int j = jb + q; float pj = shl(jb < 64 ? p0 : p1, j & 63); pj = j >= n_new ? pj : 0.f; o0 += pj * kk[q].x; o1 += pj * kk[q].y; }
#pragma unroll
            for (int q = 0; q < 8; ++q) kk[q] = kn[q]; }
#undef AS_LOAD
        { const float2 kv = *(const float2*)(kb + (size_t)(L + s - 128 * dil) * 1024 + 512); const float pj = shl(p2, 0); o0 += pj * kv.x; o1 += pj * kv.y; }
        for (int j = 0; j < n_new; ++j) { const unsigned vw = *(const unsigned*)(Z + (size_t)row_of_sample(b, s - j * dil) * NIN + C_AV + g * 512 + h * 128 + 2 * lane);
            const float pj = shl(p0, j); o0 += pj * bflo_(vw); o1 += pj * bfhi_(vw); }
        const float inv = 1.f / den;
        *(unsigned*)(OG + ((size_t)g * MPAD + row) * 512 + h * 128 + 2 * lane) = pk2(o0 * inv, o1 * inv);
        if (lane == 0) LSE[((size_t)g * MPAD + row) * 4 + h] = mx + logf(den);
    }
}
__device__ __forceinline__ void p_attn_merge(const bf16* __restrict__ OG, const float* __restrict__ LSE, bf16* __restrict__ OB, int vcu, int G, int wv) {
    const size_t nchunk = (size_t)MROWS * 64, gsz = (size_t)G * 512;
    for (size_t i0 = (size_t)vcu * 512 + otid(wv); i0 < nchunk; i0 += 4 * gsz) {
        float l[4][3]; u32x4 og[4][3];
#pragma unroll
        for (int q = 0; q < 4; ++q) { size_t i = i0 + q * gsz; i = i < nchunk ? i : nchunk - 1; const int row = (int)(i >> 6), c0 = (int)(i & 63) * 8, h = c0 >> 7;
#pragma unroll
            for (int g = 0; g < 3; ++g) { l[q][g] = LSE[((size_t)g * MPAD + row) * 4 + h]; og[q][g] = *(const u32x4*)(OG + ((size_t)g * MPAD + row) * 512 + c0); } }
#pragma unroll
        for (int q = 0; q < 4; ++q) { const size_t i = i0 + q * gsz; if (i >= nchunk) continue; const int row = (int)(i >> 6), c0 = (int)(i & 63) * 8;
            const float l0 = l[q][0], l1 = l[q][1], l2 = l[q][2];
            const float m = fmaxf(l0, fmaxf(l1, l2)); float w0 = expf(l0 - m), w1 = expf(l1 - m), w2 = expf(l2 - m); const float inv = 1.f / (w0 + w1 + w2); w0 *= inv; w1 *= inv; w2 *= inv;
            const u32x4 a = og[q][0], bq = og[q][1], c = og[q][2];
            const unsigned aw[4] = {a.x, a.y, a.z, a.w}, bw[4] = {bq.x, bq.y, bq.z, bq.w}, cw[4] = {c.x, c.y, c.z, c.w}; unsigned ow[4];
#pragma unroll
            for (int e = 0; e < 4; ++e) { const float lo = w0 * __uint_as_float(aw[e] << 16) + w1 * __uint_as_float(bw[e] << 16) + w2 * __uint_as_float(cw[e] << 16);
                const float hi = w0 * __uint_as_float(aw[e] & 0xffff0000u) + w1 * __uint_as_float(bw[e] & 0xffff0000u) + w2 * __uint_as_float(cw[e] & 0xffff0000u); ow[e] = pk2(lo, hi); }
            *(u32x4*)(OB + (size_t)row * 1536 + 1024 + c0) = (u32x4){ow[0], ow[1], ow[2], ow[3]}; }
    }
}
template <int PART  >
__device__ __forceinline__ void p_kv_out(const bf16* __restrict__ Z, const float* __restrict__ c0, const float* __restrict__ c1, const float* __restrict__ c2, float* __restrict__ out, int vcu, int G, int wv) {
    const size_t gtid = (size_t)vcu * 512 + otid(wv), gsz = (size_t)G * 512;
    for (int g = 0; g < 3; ++g) {
        const int dil = g == 0 ? 1 : (g == 1 ? 4 : 16), L = 128 * dil; const float* cache = g == 0 ? c0 : (g == 1 ? c1 : c2);
        float* op = out + (g == 0 ? O_KV0P : (g == 1 ? O_KV1P : O_KV2P)); float* os = out + (g == 0 ? O_KV0S : (g == 1 ? O_KV1S : O_KV2S));
        if (PART == 1) for (size_t i = gtid; i < (size_t)L * 256; i += gsz) { const int j = (int)(i >> 8), c = (int)(i & 255) * 4, kv = c >> 9, hd = c & 511; const int tok = TP - L + j;
            const u32x2 w = *(const u32x2*)(Z + (size_t)tok * NIN + (kv ? C_AV : C_AK) + g * 512 + hd);
            *(f32x4*)(op + (size_t)j * 1024 + c) = (f32x4){__uint_as_float(w.x << 16), __uint_as_float(w.x & 0xffff0000u), __uint_as_float(w.y << 16), __uint_as_float(w.y & 0xffff0000u)}; }
        if (PART == 1) for (size_t i = gtid; i < (size_t)NSMP * 256; i += gsz) { const int bs = (int)(i >> 8), b = bs >> 2, s = bs & 3, c = (int)(i & 255) * 4, kv = c >> 9, hd = c & 511;
            const u32x2 w = *(const u32x2*)(Z + (size_t)row_of_sample(b, s) * NIN + (kv ? C_AV : C_AK) + g * 512 + hd);
            *(f32x4*)(os + ((size_t)b * L + (L - DEC_S + s)) * 1024 + c) = (f32x4){__uint_as_float(w.x << 16), __uint_as_float(w.x & 0xffff0000u), __uint_as_float(w.y << 16), __uint_as_float(w.y & 0xffff0000u)}; }
        if (PART == 0) { const size_t per_b = (size_t)(L - DEC_S) * 256, ntot = (size_t)DEC_B * per_b;
            for (size_t i0 = gtid; i0 < ntot; i0 += 16 * gsz) { f32x4 v[16];
#pragma unroll
                for (int q = 0; q < 16; ++q) { const size_t i = i0 + q * gsz; if (i < ntot) { const size_t bb = i / per_b, e = i - bb * per_b; v[q] = __builtin_nontemporal_load((const f32x4*)(cache + bb * L * 1024 + (size_t)DEC_S * 1024) + e); } }
#pragma unroll
                for (int q = 0; q < 16; ++q) { const size_t i = i0 + q * gsz; if (i < ntot) { const size_t bb = i / per_b, e = i - bb * per_b; __builtin_nontemporal_store(v[q], (f32x4*)(os + bb * L * 1024) + e); } } } }
    }
}
__device__ __forceinline__ void kvn_addr(int i, const bf16* Z, float* out, const u32x2*& src, f32x4*& dst) {
    constexpr int P0 = 128 * 256, P1 = P0 + 512 * 256, P2 = P1 + 2048 * 256, SN = NSMP * 256;
    int g, j; bool smp = false;
    if (i < P0) { g = 0; j = i; } else if (i < P1) { g = 1; j = i - P0; } else if (i < P2) { g = 2; j = i - P1; } else { smp = true; const int r = i - P2; g = r / SN; j = r - g * SN; }
    const int L = g == 0 ? 128 : (g == 1 ? 512 : 2048), c = (j & 255) * 4, kv = c >> 9, hd = c & 511, rw = j >> 8;
    if (!smp) { src = (const u32x2*)(Z + (size_t)(TP - L + rw) * NIN + (kv ? C_AV : C_AK) + g * 512 + hd); dst = (f32x4*)(out + (g == 0 ? O_KV0P : (g == 1 ? O_KV1P : O_KV2P)) + (size_t)rw * 1024 + c); }
    else { const int b_ = rw >> 2, s_ = rw & 3; src = (const u32x2*)(Z + (size_t)row_of_sample(b_, s_) * NIN + (kv ? C_AV : C_AK) + g * 512 + hd);
           dst = (f32x4*)(out + (g == 0 ? O_KV0S : (g == 1 ? O_KV1S : O_KV2S)) + ((size_t)b_ * L + (L - DEC_S + s_)) * 1024 + c); }
}
__device__ __forceinline__ void p_kv_new(const bf16* __restrict__ Z, float* __restrict__ out, int vcu, int G, int wv) {
    constexpr int NTOT = (128 + 512 + 2048) * 256 + 3 * NSMP * 256;
    const int gtid = vcu * 512 + otid(wv), gsz = G * 512;
    for (int i0 = gtid; i0 < NTOT; i0 += 6 * gsz) { u32x2 w[6];
#pragma unroll
        for (int q = 0; q < 6; ++q) { int i = i0 + q * gsz; i = i < NTOT ? i : NTOT - 1; const u32x2* s_; f32x4* d_; kvn_addr(i, Z, out, s_, d_); w[q] = *s_; }
#pragma unroll
        for (int q = 0; q < 6; ++q) { int i = i0 + q * gsz; i = i < NTOT ? i : NTOT - 1; const u32x2* s_; f32x4* d_; kvn_addr(i, Z, out, s_, d_);
            *d_ = (f32x4){__uint_as_float(w[q].x << 16), __uint_as_float(w[q].x & 0xffff0000u), __uint_as_float(w[q].y << 16), __uint_as_float(w[q].y & 0xffff0000u)}; } }
}
__device__ __forceinline__ void p_mix(const bf16* __restrict__ Z, const bf16* __restrict__ Y1, const bf16* __restrict__ Y2, bf16* __restrict__ MIX, int vcu, int G, int wv) {
    const size_t nchunk = (size_t)MROWS * 256;
    for (size_t i = (size_t)vcu * 512 + otid(wv); i < nchunk; i += (size_t)G * 512) {
        const int row = (int)(i >> 8), c0 = (int)(i & 255) * 8;
        const u32x4 ga = *(const u32x4*)(Z + (size_t)row * NIN + C_GA + c0), gb = *(const u32x4*)(Z + (size_t)row * NIN + C_GB + c0), y1 = *(const u32x4*)(Y1 + (size_t)row * DM + c0), y2 = *(const u32x4*)(Y2 + (size_t)row * DM + c0);
        const unsigned a[4] = {ga.x, ga.y, ga.z, ga.w}, bq[4] = {gb.x, gb.y, gb.z, gb.w}, c[4] = {y1.x, y1.y, y1.z, y1.w}, d[4] = {y2.x, y2.y, y2.z, y2.w}; unsigned ow[4];
#pragma unroll
        for (int e = 0; e < 4; ++e) { const float lo = __uint_as_float(a[e] << 16) * __uint_as_float(c[e] << 16) + __uint_as_float(bq[e] << 16) * __uint_as_float(d[e] << 16);
            const float hi = __uint_as_float(a[e] & 0xffff0000u) * __uint_as_float(c[e] & 0xffff0000u) + __uint_as_float(bq[e] & 0xffff0000u) * __uint_as_float(d[e] & 0xffff0000u); ow[e] = pk2(lo, hi); }
        *(u32x4*)(MIX + (size_t)row * DM + c0) = (u32x4){ow[0], ow[1], ow[2], ow[3]};
    }
}
__device__ __forceinline__ float* yrow(float* out, int row) { return row < TP ? out + O_Y + (size_t)row * DM : out + O_YS + (size_t)(row - TP) * DM; }
__device__ __forceinline__ void p_resid1(const float* __restrict__ xp, const float* __restrict__ xs, const float* __restrict__ C, float* __restrict__ out, bf16* __restrict__ xb, float* __restrict__ r2, int vcu, int G, int wv) {
    const int tid_ = otid(wv), lane = tid_ & 63, gw = vcu * 8 + (tid_ >> 6), ngw = G * 8;
    for (int row = gw; row < MROWS; row += ngw) {
        const f32x4* src = (const f32x4*)(row < TP ? xp + (size_t)row * DM : xs + (size_t)(row - TP) * DM) + lane; const f32x4* cp = (const f32x4*)(C + (size_t)row * DM) + lane;
        f32x4* op = (f32x4*)yrow(out, row) + lane; u32x2* o = (u32x2*)(xb + (size_t)row * DM) + lane; float ss = 0.f;
#pragma unroll
        for (int j = 0; j < 8; ++j) { const f32x4 v = src[64 * j] + cp[64 * j]; ss += v.x * v.x + v.y * v.y + v.z * v.z + v.w * v.w; op[64 * j] = v; o[64 * j] = (u32x2){pk2(v.x, v.y), pk2(v.z, v.w)}; }
        ss = wave_sum(ss, lane); if (lane == 0) r2[row] = rsqrtf(ss * (1.f / DM) + EPS);
    }
}
__device__ __forceinline__ void p_conv(const bf16* __restrict__ U, const float* __restrict__ r2, const float* __restrict__ cbuf, const float* __restrict__ cw, const float* __restrict__ cb, bf16* __restrict__ ACT, float* __restrict__ out, int vcu, int G, int wv) {
    const size_t nchunk = (size_t)MROWS * (DFF / 4);
    for (size_t i = (size_t)vcu * 512 + otid(wv); i < nchunk; i += (size_t)G * 512) {
        const int row = (int)(i / (DFF / 4)), c0 = (int)(i % (DFF / 4)) * 4; const bool smp = row >= TP; const int b = (row - TP) >> 2, s = (row - TP) & 3;
        float res[2][4];
#pragma unroll
        for (int half = 0; half < 2; ++half) { const int col = c0 + half * DFF; float u0[4], u1[4], u2[4];
            { const u32x2 w = *(const u32x2*)(U + (size_t)row * NUP + col); const float r = r2[row]; u2[0] = r * __uint_as_float(w.x << 16); u2[1] = r * __uint_as_float(w.x & 0xffff0000u); u2[2] = r * __uint_as_float(w.y << 16); u2[3] = r * __uint_as_float(w.y & 0xffff0000u); }
            const bool has1 = smp ? (s >= 1) : (row >= 1), has2 = smp ? (s >= 2) : (row >= 2);
            if (has1) { const u32x2 w = *(const u32x2*)(U + (size_t)(row - 1) * NUP + col); const float r = r2[row - 1]; u1[0] = r * __uint_as_float(w.x << 16); u1[1] = r * __uint_as_float(w.x & 0xffff0000u); u1[2] = r * __uint_as_float(w.y << 16); u1[3] = r * __uint_as_float(w.y & 0xffff0000u); }
            else if (smp) { const f32x4 v = *(const f32x4*)(cbuf + ((size_t)b * 2 + 1) * NUP + col); u1[0] = v.x; u1[1] = v.y; u1[2] = v.z; u1[3] = v.w; }
            else { u1[0] = u1[1] = u1[2] = u1[3] = 0.f; }
            if (has2) { const u32x2 w = *(const u32x2*)(U + (size_t)(row - 2) * NUP + col); const float r = r2[row - 2]; u0[0] = r * __uint_as_float(w.x << 16); u0[1] = r * __uint_as_float(w.x & 0xffff0000u); u0[2] = r * __uint_as_float(w.y << 16); u0[3] = r * __uint_as_float(w.y & 0xffff0000u); }
            else if (smp) { const f32x4 v = *(const f32x4*)(cbuf + ((size_t)b * 2 + s) * NUP + col); u0[0] = v.x; u0[1] = v.y; u0[2] = v.z; u0[3] = v.w; }
            else { u0[0] = u0[1] = u0[2] = u0[3] = 0.f; }
            const f32x4 w0 = *(const f32x4*)(cw + col), w1 = *(const f32x4*)(cw + NUP + col), w2 = *(const f32x4*)(cw + 2 * NUP + col), bb = *(const f32x4*)(cb + col);
#pragma unroll
            for (int e = 0; e < 4; ++e) res[half][e] = bb[e] + w0[e] * u0[e] + w1[e] * u1[e] + w2[e] * u2[e];
            if (!smp && row >= TP - 2) *(f32x4*)(out + O_CVP + (size_t)(row - (TP - 2)) * NUP + col) = (f32x4){u2[0], u2[1], u2[2], u2[3]};
            if (smp && s >= 2) *(f32x4*)(out + O_CVS + ((size_t)b * 2 + (s - 2)) * NUP + col) = (f32x4){u2[0], u2[1], u2[2], u2[3]};
        }
        float a[4];
#pragma unroll
        for (int e = 0; e < 4; ++e) a[e] = res[0][e] * sigmoidf_(res[0][e]) * res[1][e];
        *(u32x2*)(ACT + (size_t)row * DFF + c0) = (u32x2){pk2(a[0], a[1]), pk2(a[2], a[3])};
    }
}
__device__ __forceinline__ void p_final(const float* __restrict__ C, const float* __restrict__ wf, float* __restrict__ out, int vcu, int G, int wv) {
    const int tid_ = otid(wv), lane = tid_ & 63, gw = vcu * 8 + (tid_ >> 6), ngw = G * 8;
    for (int row = gw; row < MROWS; row += ngw) {
        const f32x4* cp = (const f32x4*)(C + (size_t)row * DM) + lane; f32x4* op = (f32x4*)yrow(out, row) + lane; const f32x4* wp = (const f32x4*)wf + lane;
        f32x4 v[8]; float ss = 0.f;
#pragma unroll
        for (int j = 0; j < 8; ++j) { v[j] = op[64 * j] + cp[64 * j]; ss += v[j].x * v[j].x + v[j].y * v[j].y + v[j].z * v[j].z + v[j].w * v[j].w; }
        ss = wave_sum(ss, lane); const float rs = rsqrtf(ss * (1.f / DM) + EPS);
#pragma unroll
        for (int j = 0; j < 8; ++j) op[64 * j] = v[j] * rs * wp[64 * j];
    }
}


__device__ __forceinline__ void p_r2(const float* __restrict__ SSP, float* __restrict__ r2, int vcu, int G, int wv) {
    for (int row = vcu * 512 + otid(wv); row < MPAD; row += G * 512) { const f32x4* p = (const f32x4*)(SSP + (size_t)row * 32); float ss = 0.f;
#pragma unroll
        for (int j = 0; j < 8; ++j) { const f32x4 v = p[j]; ss += (v.x + v.y) + (v.z + v.w); }
        r2[row] = row < MROWS ? rsqrtf(ss * (1.f / DM) + EPS) : 1.f; }
}
__device__ __forceinline__ void p_final2(const float* __restrict__ SSP, const float* __restrict__ wf, float* __restrict__ out, int vcu, int G, int wv) {
    const int tid_ = otid(wv), lane = tid_ & 63, gw = vcu * 8 + (tid_ >> 6), ngw = G * 8;
    for (int row = gw; row < MROWS; row += ngw) {
        f32x4* op = (f32x4*)yrow(out, row) + lane; const f32x4* wp = (const f32x4*)wf + lane;
        const float ss = wave_sum(lane < 32 ? SSP[(size_t)row * 32 + lane] : 0.f, lane); const float rs = rsqrtf(ss * (1.f / DM) + EPS);
#pragma unroll
        for (int j = 0; j < 8; ++j) op[64 * j] = op[64 * j] * rs * wp[64 * j];
    }
}

__device__ __forceinline__ void p_reduce_out(const float* __restrict__ xs, const float* __restrict__ slab, int KS, float* __restrict__ out, bf16* __restrict__ xb, const float* __restrict__ SSP, float* __restrict__ R2, int vcu, int G, int wv) {
    const int tid_ = otid(wv), lane = tid_ & 63, gw = vcu * 8 + (tid_ >> 6), ngw = G * 8;
    for (int r = gw; r < NSMP; r += ngw) { const int row = TP + r;
        const f32x4* src = (const f32x4*)(xs + (size_t)r * DM) + lane; f32x4* op = (f32x4*)(out + O_YS + (size_t)r * DM) + lane; u32x2* o = (u32x2*)(xb + (size_t)row * DM) + lane; float ss = 0.f;
#pragma unroll
        for (int j = 0; j < 8; ++j) { f32x4 v = src[64 * j];
            for (int ks = 0; ks < KS; ++ks) v += ((const f32x4*)(slab + ((size_t)ks * 128 + r) * DM) + lane)[64 * j];
            ss += v.x * v.x + v.y * v.y + v.z * v.z + v.w * v.w; op[64 * j] = v; o[64 * j] = (u32x2){pk2(v.x, v.y), pk2(v.z, v.w)}; }
        ss = wave_sum(ss, lane);
        if (lane == 0) R2[row] = rsqrtf(ss * (1.f / DM) + EPS);
    }
    for (int row = gw; row < TP; row += ngw) {
        const float ss = wave_sum(lane < 32 ? SSP[(size_t)row * 32 + lane] : 0.f, lane); if (lane == 0) R2[row] = rsqrtf(ss * (1.f / DM) + EPS); }
}
__device__ __forceinline__ void p_final3(const float* __restrict__ SSP, const float* __restrict__ slab, int KS, const float* __restrict__ wf, float* __restrict__ out, int vcu, int G, int wv) {
    const int tid_ = otid(wv), lane = tid_ & 63, gw = vcu * 8 + (tid_ >> 6), ngw = G * 8;
    for (int row = gw; row < MROWS; row += ngw) {
        f32x4* op = (f32x4*)yrow(out, row) + lane; const f32x4* wp = (const f32x4*)wf + lane;
        if (row < TP) {
            const float ss = wave_sum(lane < 32 ? SSP[(size_t)row * 32 + lane] : 0.f, lane); const float rs = rsqrtf(ss * (1.f / DM) + EPS);
#pragma unroll
            for (int j = 0; j < 8; ++j) op[64 * j] = op[64 * j] * rs * wp[64 * j];
        } else { const int r = row - TP; f32x4 v[8]; float ss = 0.f;
#pragma unroll
            for (int j = 0; j < 8; ++j) { v[j] = op[64 * j];
                for (int ks = 0; ks < KS; ++ks) v[j] += ((const f32x4*)(slab + ((size_t)ks * 128 + r) * DM) + lane)[64 * j];
                ss += v[j].x * v[j].x + v[j].y * v[j].y + v[j].z * v[j].z + v[j].w * v[j].w; }
            ss = wave_sum(ss, lane); const float rs = rsqrtf(ss * (1.f / DM) + EPS);
#pragma unroll
            for (int j = 0; j < 8; ++j) op[64 * j] = v[j] * rs * wp[64 * j];
        }
    }
}

struct WDesc { const float* W; bf16* WT; const float* ks; int N, ldo, remap, k0, n0; bool live; };
__device__ __forceinline__ WDesc wdecode(int t, const float* w_in, const float* wpa, const float* wpb, const float* wout, const float* wup, const float* wdn, const float* nmw, const float* nfw,
                                         bf16* WinT, bf16* WpT, bf16* WoutT, bf16* WupT, bf16* WdnT, bf16* DUMP) {
    WDesc d; d.live = true; d.remap = 0; d.ks = nullptr; int nbn;
    if (t < 1600) { d.W = w_in; d.WT = WinT; d.ks = nmw; d.N = NIN; d.ldo = DM; nbn = 50; }
    else if ((t -= 1600) < 1408) { d.W = wup; d.WT = WupT; d.ks = nfw; d.N = NUP; d.ldo = DM; d.remap = 1; nbn = 44; }
    else if ((t -= 1408) < 704) { d.W = wdn; d.WT = WdnT; d.N = DM; d.ldo = DFF; nbn = 8; }
    else if ((t -= 704) < 256) { d.W = wout; d.WT = WoutT; d.N = DM; d.ldo = DM; nbn = 8; }
    else if ((t -= 256) < 128) { d.W = wpa; d.WT = WpT; d.N = DM; d.ldo = 1536; nbn = 8; }
    else if ((t -= 128) < 64) { d.W = wpb; d.WT = WpT + 1024; d.N = DM; d.ldo = 1536; nbn = 8; }
    else { d.W = w_in; d.WT = DUMP; d.N = NIN; d.ldo = DM; nbn = 50; t = 0; d.live = false; }
    d.k0 = (t / nbn) * 64; d.n0 = (t % nbn) * 256; return d;
}
__device__ __forceinline__ void p_wtrans_all(const float* w_in, const float* wpa, const float* wpb, const float* wout, const float* wup, const float* wdn, const float* nmw, const float* nfw,
                                             bf16* WinT, bf16* WpT, bf16* WoutT, bf16* WupT, bf16* WdnT, bf16* DUMP, unsigned char* lds, int vcu, int G, int wv) {
    const int tid = otid(wv), lane = tid & 63, w = tid >> 6;
    float* tile = (float*)lds;
    constexpr int NT = 1600 + 1408 + 704 + 256 + 128 + 64;
    const int niter = (NT + G - 1) / G;
    f32x4 b0[8], b1[8], b2[8]; float s0[8], s1[8], s2[8]; bool h0, h1, h2;
#define WT_LOAD(dst, sc, hs, it) do { const WDesc d = wdecode((it) * G + vcu, w_in, wpa, wpb, wout, wup, wdn, nmw, nfw, WinT, WpT, WoutT, WupT, WdnT, DUMP); \
        _Pragma("unroll") for (int i = 0; i < 8; ++i) { const int kk = 8 * i + w; dst[i] = *(const f32x4*)(d.W + (size_t)(d.k0 + kk) * d.N + d.n0 + 4 * lane); } \
        hs = d.ks != nullptr; const float* kp = hs ? d.ks + d.k0 : nmw; _Pragma("unroll") for (int i = 0; i < 8; ++i) sc[i] = kp[8 * i + w]; } while (0)
#define WT_STEP(cur, cs, hc, nxt, ns, hn, it) do { \
        _Pragma("unroll") for (int i = 0; i < 8; ++i) { float* tp = tile + (8 * i + w) * 257 + 4 * lane; const float m_ = hc ? cs[i] : 1.f; tp[0] = cur[i][0] * m_; tp[1] = cur[i][1] * m_; tp[2] = cur[i][2] * m_; tp[3] = cur[i][3] * m_; } \
        __syncthreads(); \
        WT_LOAD(nxt, ns, hn, (it) + 2); \
        { const WDesc d = wdecode((it) * G + vcu, w_in, wpa, wpb, wout, wup, wdn, nmw, nfw, WinT, WpT, WoutT, WupT, WdnT, DUMP); \
            _Pragma("unroll") for (int r = 0; r < 4; ++r) { const int q = tid + 512 * r, n = q >> 3, c = q & 7; const float* tp = tile + (8 * c) * 257 + n; \
                u32x4 o; o.x = pk2(tp[0], tp[257]); o.y = pk2(tp[2 * 257], tp[3 * 257]); o.z = pk2(tp[4 * 257], tp[5 * 257]); o.w = pk2(tp[6 * 257], tp[7 * 257]); \
                int nn = d.n0 + n; if (d.remap) nn = nn < DFF ? (nn >> 7) * 256 + (nn & 127) : ((nn - DFF) >> 7) * 256 + 128 + ((nn - DFF) & 127); \
                *(u32x4*)(d.WT + (size_t)nn * d.ldo + d.k0 + 8 * c) = o; } } \
        __syncthreads(); } while (0)
    WT_LOAD(b0, s0, h0, 0); WT_LOAD(b1, s1, h1, 1);
    int it = 0;
    for (; it + 2 < niter; it += 3) {
        WT_STEP(b0, s0, h0, b2, s2, h2, it);
        WT_STEP(b1, s1, h1, b0, s0, h0, it + 1);
        WT_STEP(b2, s2, h2, b1, s1, h1, it + 2);
    }
    if (it < niter) { WT_STEP(b0, s0, h0, b2, s2, h2, it); if (it + 1 < niter) WT_STEP(b1, s1, h1, b0, s0, h0, it + 1); }
#undef WT_STEP
#undef WT_LOAD
}

constexpr int LDS_BYTES = 147456;
constexpr int MISC_OFF = LDS_BYTES - 512;
constexpr size_t WS_CTL = 0, CTL_ZERO_BYTES = 65536;
struct Args { const float* in[20]; float* out; unsigned char* ws; };
__device__ __forceinline__ const float* ld_ptr(LAS unsigned char* p) { const unsigned lo = __builtin_amdgcn_readfirstlane(((LAS unsigned*)p)[0]), hi = __builtin_amdgcn_readfirstlane(((LAS unsigned*)p)[1]);
    return (const float*)(const __attribute__((address_space(1))) float*)(((unsigned long long)hi << 32) | lo); }

__global__ void __launch_bounds__(512, 2) mega_fwd(Args a) {
    extern __shared__ __attribute__((aligned(16))) unsigned char lds[];
    cg::grid_group grid = cg::this_grid();
    const int wv = __builtin_amdgcn_readfirstlane((int)threadIdx.x >> 6), tid = otid(wv), G = (int)gridDim.x, vcu = (int)blockIdx.x;
    float* out = a.out; unsigned char* ws = a.ws;
    bf16* WinT = (bf16*)(ws + WS_WIN); bf16* WpaT = (bf16*)(ws + WS_WPA); bf16* WpbT = (bf16*)(ws + WS_WPB); bf16* WoutT = (bf16*)(ws + WS_WOUT); bf16* WupT = (bf16*)(ws + WS_WUP); bf16* WdnT = (bf16*)(ws + WS_WDN);
    bf16* XB = (bf16*)(ws + WS_XB); float* R1 = (float*)(ws + WS_R1); float* R2 = (float*)(ws + WS_R2); float* LBV = (float*)(ws + WS_LB); bf16* Z = (bf16*)(ws + WS_Z); float* G32 = (float*)(ws + WS_G32);
    float* HST = (float*)(ws + WS_HST); float* HD = (float*)(ws + WS_HD); bf16* OA = (bf16*)(ws + WS_OA); bf16* OB = (bf16*)(ws + WS_OB); bf16* OG = (bf16*)(ws + WS_OG); float* LSE = (float*)(ws + WS_LSE);
    bf16* Y1 = (bf16*)(ws + WS_Y1); bf16* Y2 = (bf16*)(ws + WS_Y2); bf16* MIX = (bf16*)(ws + WS_MIX); float* CC = (float*)(ws + WS_C); bf16* UU = (bf16*)(ws + WS_U); bf16* ACT = (bf16*)(ws + WS_ACT); float* SSP1 = (float*)(ws + WS_SSP1); float* SSP2 = (float*)(ws + WS_SSP2); float* SLAB = (float*)(ws + WS_SLAB);

    for (int u = tid; u < 16; u += 512) ((LAS unsigned*)((LAS unsigned char*)lds + MISC_OFF))[u] = 0u;
    if (tid == 0) {
        LAS unsigned long long* pt = (LAS unsigned long long*)((LAS unsigned char*)lds + MISC_OFF + 64);
#pragma unroll
        for (int i = 0; i < 20; ++i) pt[i] = (unsigned long long)a.in[i];
    }
    __syncthreads();
#define INP(i) ld_ptr((LAS unsigned char*)lds + MISC_OFF + 64 + 8 * (i))
    if (vcu == 0) for (int u = tid; u < XCD_BAR_WORDS; u += 512) ((unsigned*)(ws + WS_CTL))[u] = 0u;
#define GRID_BAR() xcd_barrier(bar)
#define GEMM(EPI, g, E) do { pg8::StaticOrder S_; S_.init((g).M, (g).N, G, vcu); pg8::gemm_phase<EPI, pg8::StaticOrder, true, true>((PG8_LAS unsigned char*)lds, (g), S_, (E), wv); } while (0)
#define GEMM_T(EPI, g, E, KS) do { pg8::TailOrder S_; S_.init((g).M, (g).N, (g).K, (KS), G, vcu); pg8::gemm_phase<EPI, pg8::TailOrder, true, true>((PG8_LAS unsigned char*)lds, (g), S_, (E), wv); } while (0)

    { const float* nmw = INP(7); const float* w_in = INP(8); const float* lbl = INP(9); const float* wpa = INP(11); const float* wpb = INP(12); const float* wout = INP(13); const float* nfw = INP(14);
      const float* wup = INP(15); const float* wdn = INP(18); const float* x_p = INP(0); const float* x_s = INP(1); const float* ck0 = INP(3); const float* ck1 = INP(4); const float* ck2 = INP(5);
    p_wtrans_all(w_in, wpa, wpb, wout, wup, wdn, nmw, nfw, WinT, WpaT, WoutT, WupT, WdnT, ACT, lds, vcu, G, wv);
    p_xprep(x_p, x_s, XB, R1, vcu, G, wv);
    p_lb(lbl, LBV, vcu, G, wv);
    }
    __syncthreads();
    grid.sync();
    XcdBarrier bar = xcd_barrier_post((unsigned*)(ws + WS_CTL), (volatile LAS unsigned*)((LAS unsigned char*)lds + MISC_OFF) + 8);
    { pg8::Gemm g{XB, WinT, MPAD, NIN, DM, 256}; pg8::EpiInProj E{Z, G32, R1, LBV, (pg8::u32x4*)(ws + WS_Y1)}; GEMM_T(pg8::EpiInProj, g, E, 1); }
    GRID_BAR();
    { const float* ck0 = INP(3); const float* ck1 = INP(4); const float* ck2 = INP(5); const float* st_h = INP(2); const float* hnw = INP(10);
    p_kv_new(Z, out, vcu, G, wv);
    p_hgrn_local(Z, G32, (bf16*)HST, HD, ck0, ck1, ck2, out, lds, vcu, G, wv);
    p_attn_prompt(Z, OG, LSE, lds, vcu, G, wv);
    p_attn_sample(Z, ck0, ck1, ck2, OG, LSE, vcu, G, wv);
    p_hgrn_out<true>(Z, G32, nullptr, st_h, hnw, OA, out + O_HS, nullptr, nullptr, nullptr, nullptr, lds, vcu, G, wv); }
    GRID_BAR();
    p_hgrn_scan((bf16*)HST, HD, out + O_HP, vcu, G, wv);
    GRID_BAR();
    { const float* hnw = INP(10); p_hgrn_out<false>(Z, G32, (const bf16*)HST, nullptr, hnw, OA, nullptr, INP(3), INP(4), INP(5), out, lds, vcu, G, wv); }
    p_attn_merge(OG, LSE, OA, vcu, G, wv);
    GRID_BAR();
    { pg8::Gemm g{OA, WpaT, MPAD, DM, 1536, 256}; pg8::EpiMixCat E{(const pg8::u32x4*)(ws + WS_Y1), MIX}; GEMM_T(pg8::EpiMixCat, g, E, 1); }
    GRID_BAR();
    { pg8::Gemm g{MIX, WoutT, MPAD, DM, DM, 256}; pg8::EpiResid<true> E{INP(0), INP(1), out, XB, SSP1, SLAB, (pg8::f32x4*)CC}; GEMM_T(pg8::EpiResid<true>, g, E, 8); }
    GRID_BAR();
    { p_reduce_out(INP(1), SLAB, 8, out, XB, SSP1, R2, vcu, G, wv); }
    GRID_BAR();
    { pg8::Gemm g{XB, WupT, MPAD, NUP, DM, 254}; pg8::EpiConv E{ACT, R2, INP(6), INP(16), INP(17), out, (PG8_LAS unsigned char*)lds + 131072}; { pg8::TailHalves S_; S_.init(g.M, g.N, G, vcu); pg8::gemm_phase<pg8::EpiConv, pg8::TailHalves, true, true>((PG8_LAS unsigned char*)lds, g, S_, E, wv); } }
    GRID_BAR();
    { pg8::Gemm g{ACT, WdnT, MPAD, DM, DFF, 256}; pg8::EpiResid<false> E{out, out + O_YS, out, XB, SSP2, SLAB, (pg8::f32x4*)CC}; GEMM_T(pg8::EpiResid<false>, g, E, 11); }
    GRID_BAR();
    p_final3(SSP2, SLAB, 11, INP(19), out, vcu, G, wv);
}

extern "C" void kernel_launch(void* const* d_in, const int* in_sizes, int n_in, void* d_out, int out_size, void* d_ws, size_t ws_size, hipStream_t stream) {
    static int grid = 0;
    if (grid == 0) {
        if (n_in != 20 || (size_t)out_size != O_END || ws_size < WS_END) { fprintf(stderr, "kernel_launch: unexpected shapes (n_in %d out %d ws %zu need %zu)\n", n_in, out_size, ws_size, (size_t)WS_END); grid = -1; return; }
        int dev = 0, cus = 0, per_cu = 0;
        if (hipGetDevice(&dev) != hipSuccess || hipDeviceGetAttribute(&cus, hipDeviceAttributeMultiprocessorCount, dev) != hipSuccess) { grid = -1; return; }
        if (hipFuncSetAttribute((const void*)mega_fwd, hipFuncAttributeMaxDynamicSharedMemorySize, LDS_BYTES) != hipSuccess) { fprintf(stderr, "kernel_launch: hipFuncSetAttribute failed\n"); grid = -1; return; }
        if (hipOccupancyMaxActiveBlocksPerMultiprocessor(&per_cu, (const void*)mega_fwd, 512, LDS_BYTES) != hipSuccess || per_cu < 1) { fprintf(stderr, "kernel_launch: occupancy query says %d\n", per_cu); per_cu = 1; }
        (void)hipGetLastError();
        grid = cus;
    }
    if (grid < 0) return;
    Args a{};
    for (int i = 0; i < 20; ++i) a.in[i] = (const float*)d_in[i];
    a.out = (float*)d_out; a.ws = (unsigned char*)d_ws;
    void* args[] = {&a};
    hipError_t e = hipLaunchCooperativeKernel((const void*)mega_fwd, dim3(grid), dim3(512), args, LDS_BYTES, stream);
    if (e != hipSuccess) fprintf(stderr, "kernel_launch: cooperative launch failed: %s (grid %d)\n", hipGetErrorString(e), grid);
}
```

```cpp
#include <hip/hip_runtime.h>
#include <hip/hip_cooperative_groups.h>
#include <cstdio>
#include <cstdint>
namespace cg = cooperative_groups;
#define LAS __attribute__((address_space(3)))
__device__ __forceinline__ int otid(int wv) { int t; asm volatile("v_mbcnt_lo_u32_b32 %0, -1, 0\n\tv_mbcnt_hi_u32_b32 %0, -1, %0" : "=v"(t)); return (wv << 6) | t; }
__device__ __forceinline__ float shx(float v, int mask, int lane) { return __int_as_float(__builtin_amdgcn_ds_bpermute((lane ^ mask) << 2, __float_as_int(v))); }
__device__ __forceinline__ float shl(float v, int src) { return __int_as_float(__builtin_amdgcn_ds_bpermute(src << 2, __float_as_int(v))); }
__device__ __forceinline__ unsigned shlu(unsigned v, int src) { return (unsigned)__builtin_amdgcn_ds_bpermute(src << 2, (int)v); }
namespace pg8 {
#define PG8_LAS __attribute__((address_space(3)))
typedef unsigned short bf16_t;
typedef short bf16x8 __attribute__((ext_vector_type(8)));
typedef float f32x4 __attribute__((ext_vector_type(4)));
typedef unsigned u32x4 __attribute__((ext_vector_type(4)));
constexpr int BM = 256, BK = 64, HALF = 128, HTB = HALF * BK * 2  , STAGE_BYTES = 8 * HTB, NXCD = 8, WGM = 8;

__host__ __device__ __forceinline__ int lds_byte(int r, int c) { const int st = (r >> 4) * 2 + (c >> 5), rr = r & 15, cc = c & 31, ob = rr * 64 + cc * 2; return st * 1024 + (ob ^ (((ob >> 9) & 1) << 5)); }
__host__ __device__ __forceinline__ void stage_rc(int b, int& R, int& C) { const int st = b / 1024, sb = b % 1024, swz = sb ^ (((sb >> 9) & 1) << 5); R = (st >> 1) * 16 + swz / 64; C = (st & 1) * 32 + (swz % 64) / 2; }
__host__ __device__ __forceinline__ int perm32(int rho) { const int n = rho >> 4, i = rho & 15; return 8 * (i >> 2) + 4 * n + (i & 3); }

struct Unit { int pm, pn, ks, kt0, nkt; };
struct Gemm { const bf16_t* A; const bf16_t* Bt; int M, N, K, a_rows; };

struct StaticOrder {
    static constexpr bool HALVES = false;
    int nM, nN, nwg, G, c;
    __host__ __device__ void init(int M, int N, int G_, int c_) { nM = M / BM; nN = N / BM; nwg = nM * nN; G = G_; c = c_; }
    __host__ __device__ bool next(int i, Unit& u) const {
        const long L = (long)i * G + c; if (L >= nwg) return false;
        int wgid = (int)L; { const int q = nwg / NXCD, r = nwg % NXCD, xcd = wgid % NXCD, off = wgid / NXCD; wgid = (xcd < r ? xcd * (q + 1) : r * (q + 1) + (xcd - r) * q) + off; }
        const int nig = WGM * nN, gid = wgid / nig, fm = gid * WGM, gsz = (nM - fm) < WGM ? (nM - fm) : WGM;
        u.pm = fm + ((wgid % nig) % gsz); u.pn = (wgid % nig) / gsz; u.ks = -1; u.kt0 = 0; u.nkt = 0; return true;
    }
    __device__ __forceinline__ void a_ready(const Unit&) const {}
    __device__ __forceinline__ void done(const Unit&) const {}
};
struct TailHalves {
    static constexpr bool HALVES = true;
    StaticOrder base; int nN, nMf;
    __host__ __device__ void init(int M, int N, int G_, int c_) { base.init(M - BM, N, G_, c_); nN = N / BM; nMf = M / BM - 1; }
    __host__ __device__ bool next(int i, Unit& u) const {
        const long L = (long)i * base.G + base.c; if (L < base.nwg) return base.next(i, u);
        const int j = (int)(L - base.nwg); if (j >= nN * 2) return false;
        u.pm = nMf; u.pn = j >> 1; u.ks = -2 - (j & 1); u.kt0 = 0; u.nkt = 0; return true;
    }
    __device__ __forceinline__ void a_ready(const Unit&) const {}
    __device__ __forceinline__ void done(const Unit&) const {}
};
struct TailOrder {
    static constexpr bool HALVES = false;
    StaticOrder base; int nN, nMf, KS, nkt;
    __host__ __device__ void init(int M, int N, int K, int KS_, int G_, int c_) { base.init(M - BM, N, G_, c_); nN = N / BM; nMf = M / BM - 1; KS = KS_; nkt = (K / BK) / KS_; }
    __host__ __device__ bool next(int i, Unit& u) const {
        const long L = (long)i * base.G + base.c; if (L < base.nwg) return base.next(i, u);
        const int j = (int)(L - base.nwg); if (j >= nN * KS) return false;
        u.pm = nMf; u.pn = j / KS; if (KS == 1) { u.ks = -1; u.kt0 = 0; u.nkt = 0; } else { u.ks = j % KS; u.kt0 = u.ks * nkt; u.nkt = nkt; } return true;
    }
    __device__ __forceinline__ void a_ready(const Unit&) const {}
    __device__ __forceinline__ void done(const Unit&) const {}
};
__device__ __forceinline__ unsigned cvt_pk_bf16(float lo, float hi) { unsigned r; asm volatile("v_cvt_pk_bf16_f32 %0, %1, %2" : "=v"(r) : "v"(lo), "v"(hi)); return r; }
struct EpiBf16 {
    static constexpr bool PERM = true, AFTER_DRAIN = false; static constexpr int MIDK = 0;
    bf16_t* O; int ldc, pad_;
    __device__ __forceinline__ void operator()(const f32x4 (&acc)[2][2][4][2], const Unit& u, int wr, int wc, int fr, int fq) const {
        const int row0 = u.pm * BM + wr * 64 + fr; const int col0 = u.pn * BM + wc * 32 + 8 * fq;
#pragma unroll
        for (int ai = 0; ai < 2; ++ai)
#pragma unroll
            for (int m = 0; m < 4; ++m) { bf16_t* rowp = O + (size_t)(row0 + ai * HALF + m * 16) * ldc + col0;
#pragma unroll
                for (int bj = 0; bj < 2; ++bj) { const f32x4 v0 = acc[ai][bj][m][0], v1 = acc[ai][bj][m][1];
                    u32x4 w; w.x = cvt_pk_bf16(v0[0], v0[1]); w.y = cvt_pk_bf16(v0[2], v0[3]); w.z = cvt_pk_bf16(v1[0], v1[1]); w.w = cvt_pk_bf16(v1[2], v1[3]);
                    *(u32x4*)(rowp + bj * HALF) = w; } }
    }
};
struct EpiF32 {
    static constexpr bool PERM = false, AFTER_DRAIN = false; static constexpr int MIDK = 0;
    float* C; const float* bias; int ldc, pad_;
    __device__ __forceinline__ void operator()(const f32x4 (&acc)[2][2][4][2], const Unit& u, int wr, int wc, int fr, int fq) const {
        const int row0 = u.pm * BM + wr * 64 + fr, col0 = u.pn * BM + wc * 32 + 4 * fq;
        f32x4 bv[2][2];
#pragma unroll
        for (int bj = 0; bj < 2; ++bj)
#pragma unroll
            for (int n = 0; n < 2; ++n) bv[bj][n] = bias ? *(const f32x4*)(bias + col0 + bj * HALF + n * 16) : (f32x4){0.f, 0.f, 0.f, 0.f};
#pragma unroll
        for (int ai = 0; ai < 2; ++ai)
#pragma unroll
            for (int m = 0; m < 4; ++m) { float* rowp = C + (size_t)(row0 + ai * HALF + m * 16) * ldc + col0;
#pragma unroll
                for (int bj = 0; bj < 2; ++bj)
#pragma unroll
                    for (int n = 0; n < 2; ++n) *(f32x4*)(rowp + bj * HALF + n * 16) = acc[ai][bj][m][n] + bv[bj][n]; }
    }
};
typedef unsigned u32x2 __attribute__((ext_vector_type(2)));
__device__ __forceinline__ float fsigmoid(float z) { return __builtin_amdgcn_rcpf(1.f + __expf(-z)); }
__device__ __forceinline__ float bflo(unsigned w) { return __uint_as_float(w << 16); }
__device__ __forceinline__ float bfhi(unsigned w) { return __uint_as_float(w & 0xffff0000u); }
struct EpiInProj {
    static constexpr bool PERM = true, AFTER_DRAIN = false; static constexpr int MIDK = 0;
    bf16_t* Z; float* G32; const float* r1; const float* lbv; u32x4* GT;
    __device__ __forceinline__ void operator()(const f32x4 (&acc)[2][2][4][2], const Unit& u, int wr, int wc, int fr, int fq) const {
        asm volatile("" : "+v"(fr), "+v"(fq));
        const int pn = u.pn, mode = pn < 4 ? 1 : (pn < 8 ? 2 : (pn < 12 ? 0 : (pn < 16 ? 1 : (pn < 34 ? 0 : 3))));
        const int row0 = u.pm * BM + wr * 64 + fr, col0 = pn * BM + wc * 32 + 8 * fq;
        float rr[8];
#pragma unroll
        for (int q = 0; q < 8; ++q) rr[q] = r1[row0 + (q >> 2) * HALF + (q & 3) * 16];
        f32x4 lb[2][2];
        { const float* lp = lbv + (mode == 2 ? col0 - 1024 : (col0 & 511));
#pragma unroll
          for (int bj = 0; bj < 2; ++bj) { lb[bj][0] = *(const f32x4*)(lp + bj * HALF); lb[bj][1] = *(const f32x4*)(lp + bj * HALF + 4); } }
        asm volatile("" : "+v"(rr[0]), "+v"(rr[1]), "+v"(rr[2]), "+v"(rr[3]), "+v"(rr[4]), "+v"(rr[5]), "+v"(rr[6]), "+v"(rr[7]));
#pragma unroll
        for (int ai = 0; ai < 2; ++ai)
#pragma unroll
            for (int m = 0; m < 4; ++m) { if (u.pm == 64 && ai == 1) continue;     const int row = row0 + ai * HALF + m * 16; const float r = rr[ai * 4 + m]; bf16_t* rowp = Z + (size_t)row * 12800 + col0;
#pragma unroll
                for (int bj = 0; bj < 2; ++bj) { float v[8];
#pragma unroll
                    for (int j = 0; j < 8; ++j) v[j] = acc[ai][bj][m][j >> 2][j & 3] * r;
                    if (mode == 1) {
#pragma unroll
                        for (int j = 0; j < 8; ++j) v[j] = v[j] * fsigmoid(v[j]);
                    } else if (mode == 3) {
#pragma unroll
                        for (int j = 0; j < 8; ++j) v[j] = fsigmoid(v[j]);
                    } else if (mode == 2) { float gl[8];
#pragma unroll
                        for (int j = 0; j < 8; ++j) { const float k = (1.f - lb[bj][j >> 2][j & 3]) * __builtin_amdgcn_rcpf(1.f + __expf(v[j])); gl[j] = __logf(1.f - k); v[j] = k; }
                        float* gp = G32 + (size_t)row * 1024 + (col0 - 1024) + bj * HALF; *(f32x4*)gp = (f32x4){gl[0], gl[1], gl[2], gl[3]}; *(f32x4*)(gp + 4) = (f32x4){gl[4], gl[5], gl[6], gl[7]}; }
                    u32x4 w; w.x = cvt_pk_bf16(v[0], v[1]); w.y = cvt_pk_bf16(v[2], v[3]); w.z = cvt_pk_bf16(v[4], v[5]); w.w = cvt_pk_bf16(v[6], v[7]);
                    if (mode == 3) GT[((size_t)(u.pm * 16 + (pn - 34)) * 16 + (ai * 4 + m) * 2 + bj) * 512 + (wr * 4 + wc) * 64 + fq * 16 + fr] = w;
                    else *(u32x4*)(rowp + bj * HALF) = w; } }
    }
};
template <int STEP> struct EpiMix {
    static constexpr bool PERM = false, AFTER_DRAIN = false; static constexpr int MIDK = 0;
    const bf16_t* Zg; float* C; bf16_t* MIX;
    __device__ __forceinline__ void operator()(const f32x4 (&acc)[2][2][4][2], const Unit& u, int wr, int wc, int fr, int fq) const {
        asm volatile("" : "+v"(fr), "+v"(fq));
        const int row0 = u.pm * BM + wr * 64 + fr, col0 = u.pn * BM + wc * 32 + 4 * fq;
#pragma unroll
        for (int ai = 0; ai < 2; ++ai)
#pragma unroll
            for (int m = 0; m < 4; ++m) { if (u.pm == 64 && ai == 1) continue;     const int row = row0 + ai * HALF + m * 16;
#pragma unroll
                for (int bj = 0; bj < 2; ++bj)
#pragma unroll
                    for (int n = 0; n < 2; ++n) { const int col = col0 + bj * HALF + n * 16; const u32x2 gw = *(const u32x2*)(Zg + (size_t)row * 12800 + col);
                        const f32x4 g = (f32x4){bflo(gw.x), bfhi(gw.x), bflo(gw.y), bfhi(gw.y)}; float* cp = C + (size_t)row * 2048 + col;
                        if (STEP == 0) *(f32x4*)cp = g * acc[ai][bj][m][n];
                        else { const f32x4 v = *(const f32x4*)cp + g * acc[ai][bj][m][n]; *(u32x2*)(MIX + (size_t)row * 2048 + col) = (u32x2){cvt_pk_bf16(v[0], v[1]), cvt_pk_bf16(v[2], v[3])}; } } }
    }
};
template <bool WITH_BF16> struct EpiResid {
    static constexpr bool PERM = true, AFTER_DRAIN = false; static constexpr int MIDK = 0;
    const float* xp; const float* xs; float* out; bf16_t* XB; float* SSP; float* slab; f32x4* X1T;
    __device__ __forceinline__ void operator()(const f32x4 (&acc)[2][2][4][2], const Unit& u, int wr, int wc, int fr, int fq) const {
        asm volatile("" : "+v"(fr), "+v"(fq));
        const int row0 = u.pm * BM + wr * 64 + fr, col0 = u.pn * BM + wc * 32 + 8 * fq;
        f32x4* const xt = X1T + (size_t)(u.pm * 8 + u.pn) * 32 * 512 + (wr * 4 + wc) * 64 + fq * 16 + fr;
        if (u.ks >= 0) {
#pragma unroll
            for (int m = 0; m < 4; ++m) { float* sp = slab + ((size_t)u.ks * 128 + wr * 64 + m * 16 + fr) * 2048 + col0;
#pragma unroll
                for (int bj = 0; bj < 2; ++bj)
#pragma unroll
                    for (int n = 0; n < 2; ++n) *(f32x4*)(sp + bj * HALF + n * 4) = acc[0][bj][m][n]; }
            return; }
#pragma unroll
        for (int ai = 0; ai < 2; ++ai) { if (u.pm == 64 && ai == 1) continue;
            constexpr int MB = WITH_BF16 ? 2 : 4;
#pragma unroll
            for (int mp = 0; mp < 4 / MB; ++mp) {
            f32x4 bs[MB][2][2]; u32x4 bx[MB][2];
#pragma unroll
            for (int mm = 0; mm < MB; ++mm) { const int row = row0 + ai * HALF + (MB * mp + mm) * 16; const float* bp = (row < 16384 ? xp + (size_t)row * 2048 : xs + (size_t)(row - 16384) * 2048) + col0;
#pragma unroll
                for (int bj = 0; bj < 2; ++bj) {
                    if (WITH_BF16) {
#pragma unroll
                        for (int n = 0; n < 2; ++n) bs[mm][bj][n] = row < 16512 ? *(const f32x4*)(bp + bj * HALF + n * 4) : (f32x4){0.f, 0.f, 0.f, 0.f};
                    } else bx[mm][bj] = *(const u32x4*)(XB + (size_t)row * 2048 + col0 + bj * HALF); } }
#pragma unroll
            for (int mm = 0; mm < MB; ++mm) { const int m = MB * mp + mm, row = row0 + ai * HALF + m * 16; float ss = 0.f;
                if (row < 16512) { float* op = (row < 16384 ? out + (size_t)row * 2048 : out + 33554432 + (size_t)(row - 16384) * 2048) + col0;
#pragma unroll
                    for (int bj = 0; bj < 2; ++bj)
                    { f32x4 v[2];
                        if (!WITH_BF16) { const u32x4 x = bx[mm][bj]; bs[mm][bj][0] = (f32x4){bflo(x.x), bfhi(x.x), bflo(x.y), bfhi(x.y)}; bs[mm][bj][1] = (f32x4){bflo(x.z), bfhi(x.z), bflo(x.w), bfhi(x.w)}; }
#pragma unroll
                        for (int n = 0; n < 2; ++n) { v[n] = bs[mm][bj][n] + acc[ai][bj][m][n]; ss += v[n][0] * v[n][0] + v[n][1] * v[n][1] + v[n][2] * v[n][2] + v[n][3] * v[n][3];
                            if (!WITH_BF16) *(f32x4*)(op + bj * HALF + n * 4) = v[n]; }
                        if (WITH_BF16) *(u32x4*)(XB + (size_t)row * 2048 + col0 + bj * HALF) = (u32x4){cvt_pk_bf16(v[0][0], v[0][1]), cvt_pk_bf16(v[0][2], v[0][3]), cvt_pk_bf16(v[1][0], v[1][1]), cvt_pk_bf16(v[1][2], v[1][3])}; } }
                ss += shx(ss, 16, fq * 16 + fr); ss += shx(ss, 32, fq * 16 + fr);
                if (fq == 0) SSP[(size_t)row * 32 + 4 * u.pn + wc] = ss; }
            asm volatile("" ::: "memory"); } }
    }
};
struct EpiMixCat {
    static constexpr bool PERM = true, AFTER_DRAIN = false; static constexpr int MIDK = 16;
    const u32x4* GT; bf16_t* MIX;
    __device__ __forceinline__ void mid(f32x4 (&acc)[2][2][4][2], const Unit& u, int wr, int wc, int fr, int fq) const {
        asm volatile("" : "+v"(fr), "+v"(fq));
        const int row0 = u.pm * BM + wr * 64 + fr, col0 = u.pn * BM + wc * 32 + 8 * fq, gtid = (wr * 4 + wc) * 64 + fq * 16 + fr;
        const size_t ga0 = (size_t)(u.pm * 16 + u.pn) * 16 * 512, gb0 = (size_t)(u.pm * 16 + 8 + u.pn) * 16 * 512;
#pragma unroll
        for (int ai = 0; ai < 2; ++ai) { if (u.pm == 64 && ai == 1) continue;
#pragma unroll
            for (int mp = 0; mp < 2; ++mp) {
            u32x4 ga[2][2], gb[2][2];
#pragma unroll
            for (int mm = 0; mm < 2; ++mm)
#pragma unroll
                for (int bj = 0; bj < 2; ++bj) { const size_t ge = ((size_t)(ai * 4 + 2 * mp + mm) * 2 + bj) * 512 + gtid; ga[mm][bj] = GT[ga0 + ge]; gb[mm][bj] = GT[gb0 + ge]; }
#pragma unroll
            for (int mm = 0; mm < 2; ++mm)
#pragma unroll
                for (int bj = 0; bj < 2; ++bj) { const int m = 2 * mp + mm; const unsigned aw[4] = {ga[mm][bj].x, ga[mm][bj].y, ga[mm][bj].z, ga[mm][bj].w}, bw[4] = {gb[mm][bj].x, gb[mm][bj].y, gb[mm][bj].z, gb[mm][bj].w};
#pragma unroll
                    for (int q = 0; q < 4; ++q) { acc[ai][bj][m][q >> 1][2 * (q & 1)] *= bflo(aw[q]) * __builtin_amdgcn_rcpf(bflo(bw[q])); acc[ai][bj][m][q >> 1][2 * (q & 1) + 1] *= bfhi(aw[q]) * __builtin_amdgcn_rcpf(bfhi(bw[q])); } }
            asm volatile("" ::: "memory"); } }
    }
    __device__ __forceinline__ void operator()(const f32x4 (&acc)[2][2][4][2], const Unit& u, int wr, int wc, int fr, int fq) const {
        asm volatile("" : "+v"(fr), "+v"(fq));
        const int row0 = u.pm * BM + wr * 64 + fr, col0 = u.pn * BM + wc * 32 + 8 * fq, gtid = (wr * 4 + wc) * 64 + fq * 16 + fr;
        const size_t ga0 = (size_t)(u.pm * 16 + u.pn) * 16 * 512, gb0 = (size_t)(u.pm * 16 + 8 + u.pn) * 16 * 512;
#pragma unroll
        for (int ai = 0; ai < 2; ++ai) { if (u.pm == 64 && ai == 1) continue;
            u32x4 gb[4][2];
#pragma unroll
            for (int m = 0; m < 4; ++m)
#pragma unroll
                for (int bj = 0; bj < 2; ++bj) gb[m][bj] = GT[gb0 + ((size_t)(ai * 4 + m) * 2 + bj) * 512 + gtid];
#pragma unroll
            for (int m = 0; m < 4; ++m) { const int row = row0 + ai * HALF + m * 16;
#pragma unroll
                for (int bj = 0; bj < 2; ++bj) { const u32x4 g = gb[m][bj]; const f32x4 v0 = acc[ai][bj][m][0], v1 = acc[ai][bj][m][1];
                    u32x4 w; w.x = cvt_pk_bf16(v0[0] * bflo(g.x), v0[1] * bfhi(g.x)); w.y = cvt_pk_bf16(v0[2] * bflo(g.y), v0[3] * bfhi(g.y));
                    w.z = cvt_pk_bf16(v1[0] * bflo(g.z), v1[1] * bfhi(g.z)); w.w = cvt_pk_bf16(v1[2] * bflo(g.w), v1[3] * bfhi(g.w));
                    *(u32x4*)(MIX + (size_t)row * 2048 + col0 + bj * HALF) = w; } }
            asm volatile("" ::: "memory"); }
    }
};
struct EpiConv {
    static constexpr bool PERM = true, AFTER_DRAIN = false; static constexpr int MIDK = 0;
    bf16_t* ACT; const float* R2; const float* cbuf; const float* cw; const float* cb; float* out; PG8_LAS unsigned char* xch;
    __device__ __forceinline__ void operator()(const f32x4 (&acc)[2][2][4][2], const Unit& u, int wr, int wc, int fr, int fq) const {
        asm volatile("" : "+v"(fr), "+v"(fq));
        const int pm = u.pm, pn = u.pn, lane = fq * 16 + fr, c0 = 128 * pn + 32 * wc + 8 * fq;
        const bool only0 = u.ks <= -2, smpu = u.ks == -3; const int org = 254 * pm + (smpu ? 128 : 0);
        const bool smp_tile = pm == 64 && !only0;
        u32x4 pk[2][4][2]; u32x2 pa[2][4];
        float rr[8];
#pragma unroll
        for (int q = 0; q < 8; ++q) rr[q] = R2[org + 128 * (q >> 2) + 64 * wr + 16 * (q & 3) + fr];
        asm volatile("" : "+v"(rr[0]), "+v"(rr[1]), "+v"(rr[2]), "+v"(rr[3]), "+v"(rr[4]), "+v"(rr[5]), "+v"(rr[6]), "+v"(rr[7]));
#pragma unroll
        for (int ai = 0; ai < 2; ++ai)
#pragma unroll
            for (int m = 0; m < 4; ++m) { const float r = rr[ai * 4 + m];
#pragma unroll
                for (int n = 0; n < 2; ++n) { const f32x4 g = acc[ai][0][m][n] * r, a = acc[ai][1][m][n] * r;
                    pk[ai][m][n] = (u32x4){cvt_pk_bf16(g[0], g[1]), cvt_pk_bf16(g[2], g[3]), cvt_pk_bf16(a[0], a[1]), cvt_pk_bf16(a[2], a[3])}; } }
        if (fr >= 14) {
#pragma unroll
            for (int ai = 0; ai < 2; ++ai)
#pragma unroll
                for (int n = 0; n < 2; ++n) *(PG8_LAS u32x4*)(xch + ((((((ai * 2 + wr) * 2 + (fr - 14)) * 4 + wc) * 4 + fq) * 2 + n) * 16)) = pk[ai][3][n]; }
        asm volatile("s_waitcnt lgkmcnt(0)" ::: "memory"); __builtin_amdgcn_s_barrier(); asm volatile("" ::: "memory");
#pragma unroll
        for (int n = 0; n < 2; ++n) {
            const int cn = c0 + 4 * n;
            float w0[8], w1[8], w2[8], bb[8];
#pragma unroll
            for (int hf = 0; hf < 2; ++hf) { const int col = cn + hf * 5632; const f32x4 a0 = *(const f32x4*)(cw + col), a1 = *(const f32x4*)(cw + 11264 + col), a2 = *(const f32x4*)(cw + 22528 + col), a3 = *(const f32x4*)(cb + col);
#pragma unroll
                for (int e = 0; e < 4; ++e) { w0[hf * 4 + e] = a0[e]; w1[hf * 4 + e] = a1[e]; w2[hf * 4 + e] = a2[e]; bb[hf * 4 + e] = a3[e]; } }
#pragma unroll
            for (int ai = 0; ai < 2; ++ai) { if (only0 && ai == 1) continue;
                const int seg = ai * 2 + wr; const bool smp = smpu || (smp_tile && ai == 1);
                u32x4 prev = seg > 0 ? *(const PG8_LAS u32x4*)(xch + (((((((seg - 1) * 2 + (fr & 1)) * 4 + wc) * 4 + fq) * 2 + n) * 16))) : (u32x4){0u, 0u, 0u, 0u};
#pragma unroll
                for (int m = 0; m < 4; ++m) {
                    const int lr = 128 * ai + 64 * wr + 16 * m + fr, grow = org + lr;
                    const u32x4 cur = pk[ai][m][n]; u32x4 s1, s2;
#pragma unroll
                    for (int e = 0; e < 4; ++e) { const unsigned m1 = fr == 15 ? prev[e] : cur[e], m2 = fr >= 14 ? prev[e] : cur[e];
                        s1[e] = (unsigned)__builtin_amdgcn_update_dpp(0, (int)m1, 0x121, 0xf, 0xf, false); s2[e] = (unsigned)__builtin_amdgcn_update_dpp(0, (int)m2, 0x122, 0xf, 0xf, false); }
                    prev = cur;
                    float uc[8], u1[8], u2[8];
#pragma unroll
                    for (int q = 0; q < 4; ++q) { uc[2 * q] = bflo(cur[q]); uc[2 * q + 1] = bfhi(cur[q]); u1[2 * q] = bflo(s1[q]); u1[2 * q + 1] = bfhi(s1[q]); u2[2 * q] = bflo(s2[q]); u2[2 * q + 1] = bfhi(s2[q]); }
                    if (smp) {
                        const int s = fr & 3, b = (64 * wr + 16 * m + fr) >> 2;
                        if (s < 2) {
#pragma unroll
                            for (int hf = 0; hf < 2; ++hf) { const int col = cn + hf * 5632; const f32x4 b0 = *(const f32x4*)(cbuf + ((size_t)b * 2 + 0) * 11264 + col), b1 = *(const f32x4*)(cbuf + ((size_t)b * 2 + 1) * 11264 + col);
#pragma unroll
                                for (int e = 0; e < 4; ++e) { const int j = hf * 4 + e; if (s == 0) { u1[j] = b1[e]; u2[j] = b0[e]; } else { u2[j] = b1[e]; } } } }
                    }
                    float av[4];
#pragma unroll
                    for (int j = 0; j < 4; ++j) { const float cg = bb[j] + w0[j] * u2[j] + w1[j] * u1[j] + w2[j] * uc[j], ca = bb[4 + j] + w0[4 + j] * u2[4 + j] + w1[4 + j] * u1[4 + j] + w2[4 + j] * uc[4 + j];
                        av[j] = cg * fsigmoid(cg) * ca; }
                    const bool valid = smp || pm == 0 || lr >= 2;
                    if (n == 0) pa[ai][m] = (u32x2){cvt_pk_bf16(av[0], av[1]), cvt_pk_bf16(av[2], av[3])};
                    else if (valid) *(u32x4*)(ACT + (size_t)grow * 5632 + c0) = (u32x4){pa[ai][m].x, pa[ai][m].y, cvt_pk_bf16(av[0], av[1]), cvt_pk_bf16(av[2], av[3])};
                    float* so = nullptr;
                    if (smp) { if ((fr & 3) >= 2) so = out + 128997376 + ((size_t)((64 * wr + 16 * m + fr) >> 2) * 2 + ((fr & 3) - 2)) * 11264; }
                    else if (grow >= 16382 && grow < 16384) so = out + 128974848 + (size_t)(grow - 16382) * 11264;
                    if (so) { *(f32x4*)(so + cn) = (f32x4){uc[0], uc[1], uc[2], uc[3]}; *(f32x4*)(so + cn + 5632) = (f32x4){uc[4], uc[5], uc[6], uc[7]}; }
                    asm volatile("" ::: "memory");
                }
            }
        }
    }
};
template <class Epi, class Sched, bool ALIGN_EPI = false, bool SP2 = false>
__device__ __forceinline__ void gemm_phase(PG8_LAS unsigned char* lds, const Gemm g, const Sched& S, const Epi& E, int wv) {
    const int tid = otid(wv), wid = __builtin_amdgcn_readfirstlane(tid >> 6), lane = tid & 63, wr = wid >> 2, wc = wid & 3, fr = lane & 15, fq = lane >> 4;
    const int K = g.K, nt = K / BK;
    unsigned voffA[2], voffB[2];
#pragma unroll
    for (int i = 0; i < 2; ++i) { int R, C; stage_rc(tid * 16 + i * 8192, R, C); const int Rb = Epi::PERM ? ((R & ~31) + perm32(R & 31)) : R;
        voffA[i] = (unsigned)(R * K + C) * 2u; voffB[i] = (unsigned)(Rb * K + C) * 2u; }
    const size_t kstep = (size_t)(BK * 2);
    const size_t hstep = (size_t)HALF * K * 2;
    const size_t tstep = 2 * hstep;
    const size_t tstepA = (size_t)g.a_rows * K * 2;
    const unsigned ldsw = (unsigned)wid * 1024u;
    const int aoff = lds_byte(wr * 64 + fr, fq * 8), boff = lds_byte(wc * 32 + fr, fq * 8);
#define PG8_SA(b, h) (((b) * 2 + (h)) * HTB)
#define PG8_SB(b, h) ((4 + (b) * 2 + (h)) * HTB)
#define PG8_STAGE(bufoff, gbase, voff) do { _Pragma("unroll") for (int _i = 0; _i < 2; ++_i) \
        __builtin_amdgcn_global_load_lds((const unsigned*)((const char*)(gbase) + (voff)[_i]), (PG8_LAS unsigned*)(lds + (bufoff) + ldsw + _i * 8192), 16, 0, 0); } while (0)
#define PG8_LDA(dst, b, h) do { _Pragma("unroll") for (int m = 0; m < 4; ++m) _Pragma("unroll") for (int k = 0; k < 2; ++k) dst[m][k] = *(const PG8_LAS bf16x8*)(lds + PG8_SA(b, h) + aoff + m * 2048 + k * 1024); } while (0)
#define PG8_LDB(dst, b, h) do { _Pragma("unroll") for (int n = 0; n < 2; ++n) _Pragma("unroll") for (int k = 0; k < 2; ++k) dst[n][k] = *(const PG8_LAS bf16x8*)(lds + PG8_SB(b, h) + boff + n * 2048 + k * 1024); } while (0)
#define PG8_MMA(ai, bj, At, Bt) do { __builtin_amdgcn_s_setprio(1); _Pragma("unroll") for (int m = 0; m < 4; ++m) _Pragma("unroll") for (int n = 0; n < 2; ++n) _Pragma("unroll") for (int k = 0; k < 2; ++k) \
        acc[ai][bj][m][n] = __builtin_amdgcn_mfma_f32_16x16x32_bf16(Bt[n][k], At[m][k], acc[ai][bj][m][n], 0, 0, 0); __builtin_amdgcn_s_setprio(0); } while (0)
#define PG8_WAIT_V(n) asm volatile("s_waitcnt vmcnt(" #n ")" ::: "memory")
#define PG8_WAIT_L(n) asm volatile("s_waitcnt lgkmcnt(" #n ")" ::: "memory")
#define PG8_BAR __builtin_amdgcn_s_barrier()
#define PG8_SCHED __builtin_amdgcn_sched_barrier(0)
    Unit cur, nxt; int ui = 0;
    if (!S.next(0, cur)) return;
    f32x4 acc[2][2][4][2];
#pragma unroll
    for (int a = 0; a < 2; ++a)
#pragma unroll
        for (int b = 0; b < 2; ++b)
#pragma unroll
            for (int m = 0; m < 4; ++m)
#pragma unroll
                for (int n = 0; n < 2; ++n) acc[a][b][m][n] = (f32x4){0.f, 0.f, 0.f, 0.f};
    bf16x8 At[4][2], B0[2][2], B1[2][2];
    const size_t sh3 = (size_t)HALF * K * 2;
    const char* cA = (const char*)g.A + (size_t)cur.pm * tstepA + (size_t)cur.kt0 * kstep + (Sched::HALVES && cur.ks == -3 ? sh3 : (size_t)0); const char* cB = (const char*)g.Bt + (size_t)cur.pn * tstep + (size_t)cur.kt0 * kstep;
    S.a_ready(cur);
    if constexpr (SP2) {
        PG8_STAGE(PG8_SB(0, 0), cB, voffB); PG8_STAGE(PG8_SB(0, 1), cB + hstep, voffB); PG8_STAGE(PG8_SA(0, 0), cA, voffA); PG8_STAGE(PG8_SA(0, 1), cA + hstep, voffA);
        if (wr == 1) PG8_BAR;
        PG8_WAIT_V(2); PG8_BAR;
        PG8_STAGE(PG8_SB(1, 0), cB + kstep, voffB); PG8_STAGE(PG8_SA(1, 0), cA + kstep, voffA); PG8_STAGE(PG8_SB(1, 1), cB + hstep + kstep, voffB);
        PG8_WAIT_V(6); PG8_BAR;
    } else {
        PG8_STAGE(PG8_SB(0, 0), cB, voffB); PG8_STAGE(PG8_SA(0, 0), cA, voffA); PG8_STAGE(PG8_SB(0, 1), cB + hstep, voffB); PG8_STAGE(PG8_SA(0, 1), cA + hstep, voffA);
        if (wr == 1) PG8_BAR;
        PG8_WAIT_V(4); PG8_BAR;
        PG8_STAGE(PG8_SB(1, 0), cB + kstep, voffB); PG8_STAGE(PG8_SA(1, 0), cA + kstep, voffA); PG8_STAGE(PG8_SB(1, 1), cB + hstep + kstep, voffB);
        PG8_WAIT_V(6); PG8_BAR;
    }
    for (;;) {
        const bool has_next = S.next(ui + 1, nxt);
        const bool half = Sched::HALVES ? cur.ks <= -2 : (g.a_rows == BM && cur.pm == g.M / BM - 1);
        const char* nA = has_next ? (const char*)g.A + (size_t)nxt.pm * tstepA + (size_t)nxt.kt0 * kstep + (Sched::HALVES && nxt.ks == -3 ? sh3 : (size_t)0) : cA; const char* nB = has_next ? (const char*)g.Bt + (size_t)nxt.pn * tstep + (size_t)nxt.kt0 * kstep : cB;
        const int ntc = cur.ks < 0 ? nt : cur.nkt;
        for (int t = 0; t < ntc; t += 2) {
            const bool last = (t == ntc - 2);
            if constexpr (Epi::MIDK > 0) { if (t == Epi::MIDK) E.mid(acc, cur, wr, wc, fr, fq); }
            const char* a1 = cA + (size_t)(t + 1) * kstep;
            const char* a2 = last ? nA : cA + (size_t)(t + 2) * kstep; const char* b2 = last ? nB : cB + (size_t)(t + 2) * kstep;
            const char* a3 = a2 + kstep; const char* b3 = b2 + kstep;
            if (last && has_next) S.a_ready(nxt);
            if constexpr (SP2) {
            PG8_LDB(B0, 0, 0); PG8_LDB(B1, 0, 1); PG8_SCHED; PG8_LDA(At, 0, 0); PG8_STAGE(PG8_SA(1, 1), a1 + hstep, voffA);
            PG8_WAIT_V(8); PG8_WAIT_L(0); PG8_BAR; PG8_MMA(0, 0, At, B0); PG8_MMA(0, 1, At, B1); PG8_BAR; PG8_SCHED;
            if (!half) { PG8_LDA(At, 0, 1); } PG8_STAGE(PG8_SB(0, 0), b2, voffB); PG8_STAGE(PG8_SB(0, 1), b2 + hstep, voffB); PG8_STAGE(PG8_SA(0, 0), a2, voffA);
            PG8_WAIT_V(8); PG8_WAIT_L(0); PG8_BAR; if (!half) { PG8_MMA(1, 0, At, B0); PG8_MMA(1, 1, At, B1); } PG8_BAR; PG8_SCHED;
            PG8_LDB(B0, 1, 0); PG8_LDB(B1, 1, 1); PG8_SCHED; PG8_LDA(At, 1, 0); PG8_STAGE(PG8_SA(0, 1), a2 + hstep, voffA);
            PG8_WAIT_V(8); PG8_WAIT_L(0); PG8_BAR; PG8_MMA(0, 0, At, B0); PG8_MMA(0, 1, At, B1); PG8_BAR; PG8_SCHED;
            if (!half) { PG8_LDA(At, 1, 1); } PG8_STAGE(PG8_SB(1, 0), b3, voffB); PG8_STAGE(PG8_SB(1, 1), b3 + hstep, voffB); PG8_STAGE(PG8_SA(1, 0), a3, voffA);
            PG8_WAIT_V(8); PG8_WAIT_L(0); PG8_BAR; if (!half) { PG8_MMA(1, 0, At, B0); PG8_MMA(1, 1, At, B1); } PG8_BAR; PG8_SCHED;
            } else {
            PG8_LDB(B0, 0, 0); PG8_SCHED; PG8_LDA(At, 0, 0); PG8_STAGE(PG8_SA(1, 1), a1 + hstep, voffA);
            PG8_WAIT_L(8); PG8_BAR; PG8_WAIT_L(0); PG8_MMA(0, 0, At, B0); PG8_BAR; PG8_SCHED;
            PG8_LDB(B1, 0, 1); PG8_STAGE(PG8_SB(0, 0), b2, voffB);
            PG8_BAR; PG8_WAIT_L(0); PG8_MMA(0, 1, At, B1); PG8_BAR;
            PG8_LDA(At, 0, 1); PG8_STAGE(PG8_SA(0, 0), a2, voffA);
            PG8_BAR; PG8_WAIT_L(0); PG8_MMA(1, 0, At, B0); PG8_BAR; PG8_SCHED;
            PG8_STAGE(PG8_SB(0, 1), b2 + hstep, voffB);
            PG8_WAIT_V(6); PG8_BAR; PG8_MMA(1, 1, At, B1); PG8_BAR;
            PG8_LDB(B0, 1, 0); PG8_SCHED; PG8_LDA(At, 1, 0); PG8_STAGE(PG8_SA(0, 1), a2 + hstep, voffA);
            PG8_WAIT_L(8); PG8_BAR; PG8_WAIT_L(0); PG8_MMA(0, 0, At, B0); PG8_BAR; PG8_SCHED;
            PG8_LDB(B1, 1, 1); PG8_STAGE(PG8_SB(1, 0), b3, voffB);
            PG8_BAR; PG8_WAIT_L(0); PG8_MMA(0, 1, At, B1); PG8_BAR;
            PG8_LDA(At, 1, 1); PG8_STAGE(PG8_SA(1, 0), a3, voffA);
            PG8_BAR; PG8_WAIT_L(0); PG8_MMA(1, 0, At, B0); PG8_BAR; PG8_SCHED;
            PG8_STAGE(PG8_SB(1, 1), b3 + hstep, voffB);
            PG8_WAIT_V(6); PG8_BAR; PG8_MMA(1, 1, At, B1); PG8_BAR;
            }
        }
        if constexpr (ALIGN_EPI) { if (wr == 0) PG8_BAR; }
        if constexpr (!Epi::AFTER_DRAIN) { E(acc, cur, wr, wc, fr, fq); S.done(cur); }
        if (!has_next) break;
#pragma unroll
        for (int a = 0; a < 2; ++a)
#pragma unroll
            for (int b = 0; b < 2; ++b)
#pragma unroll
                for (int m = 0; m < 4; ++m)
#pragma unroll
                    for (int n = 0; n < 2; ++n) acc[a][b][m][n] = (f32x4){0.f, 0.f, 0.f, 0.f};
        cur = nxt; cA = nA; cB = nB; ++ui;
        if constexpr (ALIGN_EPI) { if (wr == 1) PG8_BAR; }
    }
    PG8_WAIT_V(0);
    if constexpr (!ALIGN_EPI) { if (wr == 0) PG8_BAR; }
    PG8_BAR;
    if constexpr (Epi::AFTER_DRAIN) { E.fused(acc, cur, wr, wc, fr, fq, lds, wid, lane); S.done(cur); }
#undef PG8_SA
#undef PG8_SB
#undef PG8_STAGE
#undef PG8_LDA
#undef PG8_LDB
#undef PG8_MMA
#undef PG8_WAIT_V
#undef PG8_WAIT_L
#undef PG8_BAR
#undef PG8_SCHED
}
}
#define XB_TMO      128
#define XB_XCNT(j)  (256  + 64 * (j))
#define XB_XSUB(j)  (1280 + 64 * (j))
#define XB_XGEN(j)  (2304 + 64 * (j))
#define XB_TOP      3328
#define XB_TOPGEN   3392
#define XCD_BAR_WORDS 3456
#define XB_SPIN_CAP (1u << 18)

__device__ __forceinline__ unsigned xb_ld(unsigned* p)              { return __hip_atomic_load(p, __ATOMIC_RELAXED, __HIP_MEMORY_SCOPE_AGENT); }
__device__ __forceinline__ unsigned xb_add(unsigned* p, unsigned v) { return __hip_atomic_fetch_add(p, v, __ATOMIC_RELAXED, __HIP_MEMORY_SCOPE_AGENT); }
__device__ __forceinline__ unsigned xb_xcc_id() { return (unsigned)__builtin_amdgcn_s_getreg((3 << 11) | 20) & 0xFu; }
#define XB_SPIN(cond, bar) do { unsigned _sp = 0; while (cond) { __builtin_amdgcn_s_sleep(1); \
    if ((++_sp & 255u) == 0u) { if (xb_ld(&(bar)[XB_TMO])) break; if (_sp > XB_SPIN_CAP) { atomicAdd(&(bar)[XB_TMO], 1u); break; } } } } while (0)

struct XcdBarrier {
    unsigned* bar; unsigned x;
    volatile LAS unsigned* st;
};

__device__ __forceinline__ XcdBarrier xcd_barrier_post(unsigned* bar, volatile LAS unsigned* st) {
    XcdBarrier b; b.bar = bar; b.x = xb_xcc_id(); b.st = st;
    if (threadIdx.x == 0) (void)xb_add(&bar[XB_XCNT(b.x)], 1u);
    return b;
}
__device__ __forceinline__ void xcd_barrier_complete(unsigned* bar, unsigned x, unsigned& nloc, unsigned& nx) {
    const unsigned G = gridDim.x * gridDim.y * gridDim.z;
    unsigned sum, cnt, mine, sp = 0u;
    for (;;) {
        sum = 0u; cnt = 0u; mine = 0u;
#pragma unroll
        for (unsigned j = 0; j < 16; ++j) { const unsigned c = xb_ld(&bar[XB_XCNT(j)]); sum += c; cnt += (c > 0u) ? 1u : 0u; mine = (j == x) ? c : mine; }
        if (sum == G) break;
        __builtin_amdgcn_s_sleep(1);
        if ((++sp & 255u) == 0u) { if (xb_ld(&bar[XB_TMO])) break; if (sp > XB_SPIN_CAP) { atomicAdd(&bar[XB_TMO], 1u); break; } }
    }
    nloc = mine > 0u ? mine : 1u; nx = cnt > 0u ? cnt : 1u;
}

__device__ __forceinline__ void xcd_barrier(const XcdBarrier& b) {
    asm volatile("s_waitcnt vmcnt(0)" ::: "memory");
    __syncthreads();
    if (threadIdx.x == 0) {
        unsigned* bar = b.bar;
        __builtin_amdgcn_s_waitcnt(0);
        unsigned nloc = b.st[0], nx = b.st[1];
        if (nloc == 0u) { xcd_barrier_complete(bar, b.x, nloc, nx); b.st[0] = nloc; b.st[1] = nx; }
        const unsigned old = xb_add(&bar[XB_XSUB(b.x)], 1u);
        const unsigned gen = old / nloc;
        if (old + 1u == (gen + 1u) * nloc) {
            __builtin_amdgcn_fence(__ATOMIC_RELEASE, "agent");
            asm volatile("s_waitcnt vmcnt(0)" ::: "memory");
            const unsigned og = xb_add(&bar[XB_TOP], 1u);
            const unsigned tg = og / nx;
            if (og + 1u == (tg + 1u) * nx) xb_add(&bar[XB_TOPGEN], 1u);
            else XB_SPIN(xb_ld(&bar[XB_TOPGEN]) == tg, bar);
            __builtin_amdgcn_fence(__ATOMIC_ACQUIRE, "agent");
            xb_add(&bar[XB_XGEN(b.x)], 1u);
            asm volatile("s_waitcnt vmcnt(0)" ::: "memory");
        } else {
            XB_SPIN(xb_ld(&bar[XB_XGEN(b.x)]) == gen, bar);
            __builtin_amdgcn_fence(__ATOMIC_ACQUIRE, "agent");
            asm volatile("s_waitcnt vmcnt(0)" ::: "memory");
        }
    }
    __syncthreads();
}

typedef unsigned short bf16;
typedef short bf16x8 __attribute__((ext_vector_type(8)));
typedef float f32x4 __attribute__((ext_vector_type(4)));
typedef unsigned u32x4 __attribute__((ext_vector_type(4)));
typedef unsigned u32x2 __attribute__((ext_vector_type(2)));

constexpr int DM = 2048, TP = 16384, DEC_B = 32, DEC_S = 4, NSMP = DEC_B * DEC_S, MROWS = TP + NSMP, MPAD = 16640;
constexpr int NIN = 12800, DFF = 5632, NUP = 2 * DFF;
constexpr int C_ZQ = 0, C_ZF = 1024, C_ZI = 2048, C_ZG = 3072, C_AQ = 4096, C_AK = 5632, C_AV = 7168, C_GA = 8704, C_GB = 10752;
constexpr int NCHUNK = TP / 64;
constexpr float EPS = 1e-6f;
constexpr size_t O_Y = 0, O_YS = 33554432, O_HP = 33816576, O_HS = 33947648, O_KV0P = 38141952, O_KV0S = 38273024, O_KV1P = 42467328, O_KV1S = 42991616,
                 O_KV2P = 59768832, O_KV2S = 61865984, O_CVP = 128974848, O_CVS = 128997376, O_END = 129718272;
constexpr size_t MiB = 1u << 20;
constexpr size_t WS_WIN = 1 * MiB;
constexpr size_t WS_WPA = WS_WIN + (size_t)NIN * DM * 2;
constexpr size_t WS_WPB = WS_WPA + (size_t)DM * 1024 * 2;
constexpr size_t WS_WOUT = WS_WPB + (size_t)DM * 512 * 2;
constexpr size_t WS_WUP = WS_WOUT + (size_t)DM * DM * 2;
constexpr size_t WS_WDN = WS_WUP + (size_t)NUP * DM * 2;
constexpr size_t WS_XB = WS_WDN + (size_t)DM * DFF * 2;
constexpr size_t WS_R1 = WS_XB + (size_t)MPAD * DM * 2;
constexpr size_t WS_R2 = WS_R1 + (size_t)MPAD * 4;
constexpr size_t WS_LB = WS_R2 + (size_t)MPAD * 4;
constexpr size_t WS_Z = WS_LB + 4096;
constexpr size_t WS_G32 = WS_Z + (size_t)MPAD * NIN * 2;
constexpr size_t WS_HST = WS_G32 + (size_t)MPAD * 1024 * 4;
constexpr size_t WS_HD = WS_HST + (size_t)8 * NCHUNK * 16384 * 4;
constexpr size_t WS_OA = WS_HD + (size_t)8 * NCHUNK * 128 * 4;
constexpr size_t WS_OB = WS_OA + (size_t)MPAD * 1536 * 2;
constexpr size_t WS_OG = WS_OB + (size_t)MPAD * 512 * 2;
constexpr size_t WS_LSE = WS_OG + (size_t)3 * MPAD * 512 * 2;
constexpr size_t WS_Y1 = WS_LSE + (size_t)3 * MPAD * 4 * 4;
constexpr size_t WS_Y2 = WS_Y1 + (size_t)MPAD * DM * 2;
constexpr size_t WS_MIX = WS_Y2 + (size_t)MPAD * DM * 2;
constexpr size_t WS_C = WS_MIX + (size_t)MPAD * DM * 2;
constexpr size_t WS_U = WS_C + (size_t)MPAD * DM * 4;
constexpr size_t WS_ACT = WS_U + (size_t)MPAD * NUP * 2;
constexpr size_t WS_SSP1 = WS_ACT + (size_t)MPAD * DFF * 2;
constexpr size_t WS_SSP2 = WS_SSP1 + (size_t)MPAD * 32 * 4;
constexpr size_t WS_SLAB = WS_SSP2 + (size_t)MPAD * 32 * 4;
constexpr size_t WS_END = WS_SLAB + (size_t)16 * 128 * 2048 * 4;

__device__ __forceinline__ float bf2f(bf16 b) { return __uint_as_float(((unsigned)b) << 16); }
__device__ __forceinline__ unsigned pk2(float lo, float hi) { unsigned r; asm volatile("v_cvt_pk_bf16_f32 %0, %1, %2" : "=v"(r) : "v"(lo), "v"(hi)); return r; }
__device__ __forceinline__ unsigned f2bf(float f) { return pk2(f, f) & 0xffffu; }
__device__ __forceinline__ float wave_sum(float v, int lane) {
#pragma unroll
    for (int o = 1; o < 64; o <<= 1) v += shx(v, o, lane);
    return v;
}
__device__ __forceinline__ float bflo_(unsigned w) { return __uint_as_float(w << 16); }
__device__ __forceinline__ float bfhi_(unsigned w) { return __uint_as_float(w & 0xffff0000u); }
__device__ __forceinline__ float sigmoidf_(float z) { return 1.f / (1.f + expf(-z)); }
__device__ __forceinline__ int row_of_sample(int b, int s) { return TP + b * DEC_S + s; }

#define MFMA16(a, b, c) __builtin_amdgcn_mfma_f32_16x16x32_bf16((a), (b), (c), 0, 0, 0)
__device__ __forceinline__ bf16x8 ldfrag(const bf16* base, int ld, int r0, int k0, int lane) { return *(const bf16x8*)(base + (r0 + (lane & 15)) * ld + k0 + 8 * (lane >> 4)); }

template <bool REMAP_UP  >
__device__ __forceinline__ void p_wtrans(const float* __restrict__ W, int K, int N, bf16* __restrict__ WT, int ldo  , const float* __restrict__ ks, unsigned char* lds, int vcu, int G, int wv) {
    const int tfull = otid(wv);
    float (*tile)[65] = (float (*)[65])(lds + (tfull >> 8) * 16640);
    const int nbn = N / 64, ntile = (K / 64) * nbn, tid = tfull & 255;
    for (int base = 2 * vcu; base < ntile; base += 2 * G) {
        const int it = base + (tfull >> 8); const bool live = it < ntile;
        const int k0 = live ? (it / nbn) * 64 : 0, n0 = live ? (it % nbn) * 64 : 0;
        __syncthreads();
#pragma unroll 4
        for (int i = 0; i < 16; ++i) { const int kk = i * 4 + (tid >> 6), c = tid & 63; float v = W[(size_t)(k0 + kk) * N + n0 + c]; if (ks) v *= ks[k0 + kk]; tile[kk][c] = v; }
        __syncthreads();
        const int n = tid >> 2, kc = (tid & 3) * 16;
        if (live)
#pragma unroll
        for (int h = 0; h < 2; ++h) { u32x4 o; const int kb = kc + h * 8;
            o.x = pk2(tile[kb + 0][n], tile[kb + 1][n]); o.y = pk2(tile[kb + 2][n], tile[kb + 3][n]); o.z = pk2(tile[kb + 4][n], tile[kb + 5][n]); o.w = pk2(tile[kb + 6][n], tile[kb + 7][n]);
            int nn = n0 + n; if (REMAP_UP) nn = nn < DFF ? (nn >> 7) * 256 + (nn & 127) : ((nn - DFF) >> 7) * 256 + 128 + ((nn - DFF) & 127);
            *(u32x4*)(WT + (size_t)nn * ldo + k0 + kb) = o; }
    }
}
__device__ __forceinline__ void p_xprep(const float* __restrict__ xp, const float* __restrict__ xs, bf16* __restrict__ xb, float* __restrict__ r1, int vcu, int G, int wv) {
    const int tid_ = otid(wv), lane = tid_ & 63, gw = vcu * 8 + (tid_ >> 6), ngw = G * 8;
    for (int row = gw; row < MPAD; row += ngw) {
        u32x2* o = (u32x2*)(xb + (size_t)row * DM) + lane;
        if (row >= MROWS) {
#pragma unroll
            for (int j = 0; j < 8; ++j) o[64 * j] = (u32x2){0u, 0u};
            if (lane == 0) r1[row] = 1.f; continue; }
        const f32x4* src = (const f32x4*)(row < TP ? xp + (size_t)row * DM : xs + (size_t)(row - TP) * DM) + lane;
        f32x4 v[8]; float ss = 0.f;
#pragma unroll
        for (int j = 0; j < 8; ++j) { v[j] = src[64 * j]; ss += v[j].x * v[j].x + v[j].y * v[j].y + v[j].z * v[j].z + v[j].w * v[j].w; }
        ss = wave_sum(ss, lane);
#pragma unroll
        for (int j = 0; j < 8; ++j) o[64 * j] = (u32x2){pk2(v[j].x, v[j].y), pk2(v[j].z, v[j].w)};
        if (lane == 0) r1[row] = rsqrtf(ss * (1.f / DM) + EPS);
    }
}
__device__ __forceinline__ void p_lb(const float* __restrict__ lbl, float* __restrict__ lbv, int vcu, int G, int wv) { const int i = vcu * 512 + otid(wv); if (i < 1024) lbv[i] = 1.f / (1.f + expf(lbl[1024 + i] - lbl[i])); }

__device__ __forceinline__ void p_act_in(bf16* __restrict__ Z, const float* __restrict__ r1, const float* __restrict__ lbv, float* __restrict__ g32, int vcu, int G, int wv) {
    const size_t nchunk = (size_t)MROWS * (NIN / 8);
    for (size_t i = (size_t)vcu * 512 + otid(wv); i < nchunk; i += (size_t)G * 512) {
        const int row = (int)(i / (NIN / 8)), c0 = (int)(i % (NIN / 8)) * 8;
        u32x4* p = (u32x4*)(Z + (size_t)row * NIN + c0); const u32x4 w = *p; const float r = r1[row];
        float z[8]; z[0] = __uint_as_float(w.x << 16); z[1] = __uint_as_float(w.x & 0xffff0000u); z[2] = __uint_as_float(w.y << 16); z[3] = __uint_as_float(w.y & 0xffff0000u);
        z[4] = __uint_as_float(w.z << 16); z[5] = __uint_as_float(w.z & 0xffff0000u); z[6] = __uint_as_float(w.w << 16); z[7] = __uint_as_float(w.w & 0xffff0000u);
#pragma unroll
        for (int j = 0; j < 8; ++j) z[j] *= r;
        if (c0 < C_ZF || (c0 >= C_ZG && c0 < C_AQ)) {
#pragma unroll
            for (int j = 0; j < 8; ++j) z[j] = z[j] * sigmoidf_(z[j]);
        } else if (c0 < C_ZI) {
            float gl[8];
#pragma unroll
            for (int j = 0; j < 8; ++j) { const float lb = lbv[c0 - C_ZF + j]; const float f = lb + (1.f - lb) * sigmoidf_(z[j]); gl[j] = logf(f); z[j] = 1.f - f; }
            f32x4* gp = (f32x4*)(g32 + (size_t)row * 1024 + (c0 - C_ZF)); gp[0] = (f32x4){gl[0], gl[1], gl[2], gl[3]}; gp[1] = (f32x4){gl[4], gl[5], gl[6], gl[7]};
        } else if (c0 >= C_GA) {
#pragma unroll
            for (int j = 0; j < 8; ++j) z[j] = sigmoidf_(z[j]);
        }
        u32x4 o; o.x = pk2(z[0], z[1]); o.y = pk2(z[2], z[3]); o.z = pk2(z[4], z[5]); o.w = pk2(z[6], z[7]); *p = o;
    }
}


constexpr int KVC_N0 = DEC_B * (128 - DEC_S) * 256, KVC_N1 = DEC_B * (512 - DEC_S) * 256, KVC_N2 = DEC_B * (2048 - DEC_S) * 256, KVC_NTOT = KVC_N0 + KVC_N1 + KVC_N2;
__device__ __forceinline__ bool kvc_addr(int i, const float* c0, const float* c1, const float* c2, float* out, const f32x4*& src, f32x4*& dst) {
    if (i >= KVC_NTOT) return false;
    const float* cache; float* os; int L;
    if (i < KVC_N0) { cache = c0; os = out + O_KV0S; L = 128; } else if ((i -= KVC_N0) < KVC_N1) { cache = c1; os = out + O_KV1S; L = 512; } else { i -= KVC_N1; cache = c2; os = out + O_KV2S; L = 2048; }
    const int per_b = (L - DEC_S) * 256, b = i / per_b, e = i - b * per_b;
    src = (const f32x4*)(cache + (size_t)b * L * 1024 + (size_t)DEC_S * 1024) + e; dst = (f32x4*)(os + (size_t)b * L * 1024) + e; return true;
}
struct KvIter {
    const f32x4* src; f32x4* dst; int i, e, per_b; bool ok;
    __device__ __forceinline__ void decode(const float* c0, const float* c1, const float* c2, float* out) {
        ok = i < KVC_NTOT; int j = i; const float* cache = c0; float* os = out + O_KV0S; int L = 128;
        if (j >= KVC_N0) { j -= KVC_N0; cache = c1; os = out + O_KV1S; L = 512; if (j >= KVC_N1) { j -= KVC_N1; cache = c2; os = out + O_KV2S; L = 2048; } }
        per_b = (L - DEC_S) * 256; const int b = ok ? j / per_b : 0; e = ok ? j - b * per_b : 0;
        src = (const f32x4*)(cache + (size_t)b * L * 1024 + (size_t)DEC_S * 1024) + e; dst = (f32x4*)(os + (size_t)b * L * 1024) + e;
    }
    __device__ __forceinline__ void start(int i0, const float* c0, const float* c1, const float* c2, float* out) { i = i0; decode(c0, c1, c2, out); }
    __device__ __forceinline__ void next(const float* c0, const float* c1, const float* c2, float* out) { i += 512; e += 512; src += 512; dst += 512; if (e >= per_b || i >= KVC_NTOT) decode(c0, c1, c2, out); }
};
template <int NPT> struct KvCopy {
    f32x4 v[NPT];
    __device__ __forceinline__ void issue(int first, int tid, const float* c0, const float* c1, const float* c2, float* out) {
        KvIter it; it.start(first + tid, c0, c1, c2, out);
#pragma unroll
        for (int q = 0; q < NPT; ++q) { if (it.ok) v[q] = __builtin_nontemporal_load(it.src); it.next(c0, c1, c2, out); }
    }
    __device__ __forceinline__ void commit(int first, int tid, const float* c0, const float* c1, const float* c2, float* out) {
        KvIter it; it.start(first + tid, c0, c1, c2, out);
#pragma unroll
        for (int q = 0; q < NPT; ++q) { if (it.ok) __builtin_nontemporal_store(v[q], it.dst); it.next(c0, c1, c2, out); }
    }
};
constexpr int KVC_LOCAL_NPT = 16, KVC_OUT_NPT = 8, KVC_OUT_BASE = 8 * NCHUNK * 512 * KVC_LOCAL_NPT;
static_assert(KVC_OUT_BASE + 8 * NCHUNK * 512 * KVC_OUT_NPT >= KVC_NTOT, "the carried KV copy covers every piece");
__device__ __forceinline__ void p_hgrn_local(const bf16* __restrict__ Z, const float* __restrict__ g32, bf16* __restrict__ HSTB, float* __restrict__ HD, const float* kc0, const float* kc1, const float* kc2, float* out, unsigned char* lds, int vcu, int G, int wv) {
    bf16* KxT = (bf16*)lds;
    bf16* VT = KxT + 128 * 72;
    float (*tot)[128] = (float (*)[128])(VT + 128 * 72);
    float* scl = (float*)tot + 512;
    const int tid = otid(wv), lane = tid & 63, w = tid >> 6;
    const int k = tid & 127, part = tid >> 7;
    float gl[16]; unsigned short kr[16]; u32x4 va, vc;
#define HL_LOAD(item_) do { const int h_ = (item_) / NCHUNK, n_ = (item_) % NCHUNK, row0_ = n_ * 64 + part * 16; \
        _Pragma("unroll") for (int i = 0; i < 16; ++i) { gl[i] = g32[(size_t)(row0_ + i) * 1024 + h_ * 128 + k]; kr[i] = Z[(size_t)(row0_ + i) * NIN + C_ZF + h_ * 128 + k]; } \
        const bf16* vp_ = Z + (size_t)(n_ * 64 + (tid >> 3)) * NIN + C_ZI + h_ * 128 + (tid & 7) * 16; va = *(const u32x4*)vp_; vc = *(const u32x4*)(vp_ + 8); } while (0)
    if (vcu < 8 * NCHUNK) HL_LOAD(vcu);
    for (int item = vcu; item < 8 * NCHUNK; item += G) {
        KvCopy<KVC_LOCAL_NPT> cp; cp.issue(item * 512 * KVC_LOCAL_NPT, tid, kc0, kc1, kc2, out);
        __syncthreads();
        float b[16]; { float c = 0.f;
#pragma unroll
            for (int i = 0; i < 16; ++i) { c += gl[i]; b[i] = c; }
            tot[part][k] = c; }
        {
            const int t = tid >> 3, dv0 = (tid & 7) * 16; const unsigned ww[8] = {va.x, va.y, va.z, va.w, vc.x, vc.y, vc.z, vc.w};
#pragma unroll
            for (int j = 0; j < 8; ++j) { VT[(dv0 + 2 * j) * 72 + t] = (bf16)(ww[j] & 0xffffu); VT[(dv0 + 2 * j + 1) * 72 + t] = (bf16)(ww[j] >> 16); }
        }
        __syncthreads();
        float off = 0.f;
#pragma unroll
        for (int p = 0; p < 4; ++p) if (p < part) off += tot[p][k];
        const float R = tot[0][k] + tot[1][k], b63 = R + tot[2][k] + tot[3][k];
        unsigned pk[8];
#pragma unroll
        for (int i = 0; i < 16; i += 2) pk[i >> 1] = pk2(bf2f(kr[i]) * __expf(fminf(R - (off + b[i]), 80.f)), bf2f(kr[i + 1]) * __expf(fminf(R - (off + b[i + 1]), 80.f)));
        u32x4* dst = (u32x4*)(KxT + k * 72 + part * 16); dst[0] = (u32x4){pk[0], pk[1], pk[2], pk[3]}; dst[1] = (u32x4){pk[4], pk[5], pk[6], pk[7]};
        if (part == 0) { scl[k] = __expf(b63 - R); HD[(size_t)item * 128 + k] = __expf(b63); }
        __syncthreads();
        if (item + G < 8 * NCHUNK) HL_LOAD(item + G);
        f32x4 acc[8];
#pragma unroll
        for (int kt = 0; kt < 8; ++kt) acc[kt] = (f32x4){0.f, 0.f, 0.f, 0.f};
#pragma unroll
        for (int ks = 0; ks < 2; ++ks) { const bf16x8 a = ldfrag(VT, 72, 16 * w, 32 * ks, lane);
#pragma unroll
            for (int kt = 0; kt < 8; ++kt) { const bf16x8 bb = ldfrag(KxT, 72, 16 * kt, 32 * ks, lane); acc[kt] = MFMA16(bb, a, acc[kt]); } }
        bf16* dstS = HSTB + (size_t)item * 16384 + (16 * w + (lane & 15)) * 128 + 4 * (lane >> 4);
#pragma unroll
        for (int kt = 0; kt < 8; ++kt) { const f32x4 s = *(const f32x4*)(scl + 16 * kt + 4 * (lane >> 4));
            *(u32x2*)(dstS + 16 * kt) = (u32x2){pk2(acc[kt][0] * s[0], acc[kt][1] * s[1]), pk2(acc[kt][2] * s[2], acc[kt][3] * s[3])}; }
        cp.commit(item * 512 * KVC_LOCAL_NPT, tid, kc0, kc1, kc2, out);
    }
#undef HL_LOAD
}
__device__ __forceinline__ void p_hgrn_scan(bf16* __restrict__ HSTB, const float* __restrict__ HD, float* __restrict__ out_hp, int vcu, int G, int wv) {
  if (wv < 4) for (int idx = vcu * 256 + otid(wv); idx < 8 * 8192; idx += G * 256) {
    const int h = idx >> 13, rem = (idx & 8191) * 2, k = rem & 127, dv = rem >> 7;
    float S0 = 0.f, S1 = 0.f;
    unsigned u[16], un[16]; float2 d[16], dn[16];
#pragma unroll
    for (int j = 0; j < 16; ++j) { u[j] = *(const unsigned*)(HSTB + ((size_t)(h * NCHUNK + j) << 14) + rem); d[j] = *(const float2*)(HD + (size_t)(h * NCHUNK + j) * 128 + k); }
    for (int n0 = 0; n0 < NCHUNK; n0 += 16) {
        if (n0 + 16 < NCHUNK) {
#pragma unroll
            for (int j = 0; j < 16; ++j) { un[j] = *(const unsigned*)(HSTB + ((size_t)(h * NCHUNK + n0 + 16 + j) << 14) + rem); dn[j] = *(const float2*)(HD + (size_t)(h * NCHUNK + n0 + 16 + j) * 128 + k); } }
#pragma unroll
        for (int j = 0; j < 16; ++j) { *(unsigned*)(HSTB + ((size_t)(h * NCHUNK + n0 + j) << 14) + rem) = pk2(S0, S1); S0 = d[j].x * S0 + bflo_(u[j]); S1 = d[j].y * S1 + bfhi_(u[j]); }
#pragma unroll
        for (int j = 0; j < 16; ++j) { u[j] = un[j]; d[j] = dn[j]; }
    }
    out_hp[h * 16384 + k * 128 + dv] = S0; out_hp[h * 16384 + (k + 1) * 128 + dv] = S1;
  }
}
template <bool SAMPLE>
__device__ __forceinline__ void p_hgrn_out(const bf16* __restrict__ Z, const float* __restrict__ g32, const bf16* __restrict__ HSTB, const float* __restrict__ S0in,
                                           const float* __restrict__ nw, bf16* __restrict__ OA, float* __restrict__ out_hs, const float* kc0, const float* kc1, const float* kc2, float* outp, unsigned char* smem, int vcu, int G, int wv) {
    bf16* Acat = (bf16*)smem;
    bf16* Kx = Acat + 64 * 200;
    bf16* Bcat = Kx + 64 * 136;
    float* osh = (float*)(Bcat + 128 * 200);
    float* tot = osh + 64 * 132;
    float* eR = tot + 512;
    float* wk = eR + 128;
    float* vv = wk + 512;
    float* nwl = vv + 512;
    const int tid = otid(wv), lane = tid & 63, w = tid >> 6;
    __syncthreads();
    nwl[tid] = nw[tid]; nwl[512 + tid] = nw[512 + tid];
    const int nitem = SAMPLE ? DEC_B * 8 : 8 * NCHUNK;
    float pg[16]; unsigned short pq[16], pkk[16]; u32x4 pva, pvc, pz0, pz1;
#define HO_LOAD(item_) do { const int h_ = (item_) / NCHUNK, n_ = (item_) % NCHUNK, r0_ = n_ * 64 + (tid >> 7) * 16, kq_ = h_ * 128 + (tid & 127); \
        _Pragma("unroll") for (int i = 0; i < 16; ++i) { pg[i] = g32[(size_t)(r0_ + i) * 1024 + kq_]; pq[i] = Z[(size_t)(r0_ + i) * NIN + C_ZQ + kq_]; pkk[i] = Z[(size_t)(r0_ + i) * NIN + C_ZF + kq_]; } \
        const bf16* zp_ = Z + (size_t)(n_ * 64 + (tid >> 3)) * NIN + h_ * 128 + (tid & 7) * 16; pva = *(const u32x4*)(zp_ + C_ZI); pvc = *(const u32x4*)(zp_ + C_ZI + 8); pz0 = *(const u32x4*)(zp_ + C_ZG); pz1 = *(const u32x4*)(zp_ + C_ZG + 8); } while (0)
    if (!SAMPLE && vcu < nitem) HO_LOAD(vcu);
    for (int item = vcu; item < nitem; item += G) {
        const int h = SAMPLE ? (item & 7) : item / NCHUNK, n = SAMPLE ? (item >> 3) : item % NCHUNK;
        __syncthreads();
        const int k = tid & 127, part = tid >> 7;
        float b[16], gq[16], gk[16];
        if (!SAMPLE) { float c = 0.f;
#pragma unroll
            for (int i = 0; i < 16; ++i) { c += pg[i]; b[i] = c; gq[i] = bf2f(pq[i]); gk[i] = bf2f(pkk[i]); }
            tot[part * 128 + k] = c;
        } else { float c = 0.f; float g4[4]; unsigned short q4[4], k4[4];
#pragma unroll
            for (int i = 0; i < 4; ++i) { const int row = row_of_sample(n, i); g4[i] = g32[(size_t)row * 1024 + h * 128 + k]; q4[i] = Z[(size_t)row * NIN + C_ZQ + h * 128 + k]; k4[i] = Z[(size_t)row * NIN + C_ZF + h * 128 + k]; }
#pragma unroll
            for (int i = 0; i < 16; ++i) { const bool ok = part == 0 && i < DEC_S;
                const float g = ok ? g4[i & 3] : 0.f; c += g; b[i] = c; gq[i] = ok ? bf2f(q4[i & 3]) : 0.f; gk[i] = ok ? bf2f(k4[i & 3]) : 0.f; }
            tot[part * 128 + k] = c; }
        f32x4 sreg[8]; u32x4 zg0, zg1;
        if (!SAMPLE) { const u32x4* sp = (const u32x4*)(HSTB + (size_t)item * 16384 + (tid >> 2) * 128 + (tid & 3) * 32);
#pragma unroll
            for (int q = 0; q < 4; ++q) { const u32x4 w_ = sp[q]; sreg[2 * q] = (f32x4){bflo_(w_.x), bfhi_(w_.x), bflo_(w_.y), bfhi_(w_.y)}; sreg[2 * q + 1] = (f32x4){bflo_(w_.z), bfhi_(w_.z), bflo_(w_.w), bfhi_(w_.w)}; }
        } else { const float* sp = S0in + ((size_t)(n * 8 + h) * 128 + (tid >> 2)) * 128 + (tid & 3) * 32;
#pragma unroll
            for (int q = 0; q < 8; ++q) sreg[q] = *(const f32x4*)(sp + 4 * q); }
        { const int t = tid >> 3, pc = (tid & 7) * 16; const bool ok = !SAMPLE || t < DEC_S; const int row = SAMPLE ? row_of_sample(n, t & 3) : n * 64 + t;
            zg0 = (u32x4){0u, 0u, 0u, 0u}; zg1 = zg0; if (!SAMPLE) { zg0 = pz0; zg1 = pz1; } else if (ok) { const bf16* gp = Z + (size_t)row * NIN + C_ZG + h * 128 + pc; zg0 = *(const u32x4*)gp; zg1 = *(const u32x4*)(gp + 8); } }
        KvCopy<KVC_OUT_NPT> cp; if (!SAMPLE) cp.issue(KVC_OUT_BASE + item * 512 * KVC_OUT_NPT, tid, kc0, kc1, kc2, outp);
        {
            const int t = tid >> 3, dv0 = (tid & 7) * 16; const bool ok = !SAMPLE || t < DEC_S; const int row = SAMPLE ? row_of_sample(n, t & 3) : n * 64 + t;
            const bf16* vp = Z + (size_t)row * NIN + C_ZI + h * 128 + dv0; u32x4 a = (u32x4){0u, 0u, 0u, 0u}, c = a; if (!SAMPLE) { a = pva; c = pvc; } else if (ok) { a = *(const u32x4*)vp; c = *(const u32x4*)(vp + 8); }
            const unsigned ww[8] = {a.x, a.y, a.z, a.w, c.x, c.y, c.z, c.w};
#pragma unroll
            for (int j = 0; j < 8; ++j) { Bcat[(dv0 + 2 * j) * 200 + 128 + t] = (bf16)(ww[j] & 0xffffu); Bcat[(dv0 + 2 * j + 1) * 200 + 128 + t] = (bf16)(ww[j] >> 16);
                if (SAMPLE && t < DEC_S) { vv[t * 128 + dv0 + 2 * j] = bf2f((bf16)(ww[j] & 0xffffu)); vv[t * 128 + dv0 + 2 * j + 1] = bf2f((bf16)(ww[j] >> 16)); } }
        }
        __syncthreads();
        float off = 0.f;
#pragma unroll
        for (int p = 0; p < 4; ++p) if (p < part) off += tot[p * 128 + k];
        const float R = tot[k] + tot[128 + k], b63 = R + tot[256 + k] + tot[384 + k];
#pragma unroll
        for (int i = 0; i < 16; ++i) { const int t = part * 16 + i; const float bt = off + b[i];
            Acat[t * 200 + k] = (bf16)f2bf(gq[i] * __expf(fminf(bt - R, 80.f))); Kx[t * 136 + k] = (bf16)f2bf(gk[i] * __expf(fminf(R - bt, 80.f)));
            if (SAMPLE && t < DEC_S) wk[t * 128 + k] = gk[i] * expf(b63 - bt); }
        if (part == 0) eR[k] = expf(R);
        __syncthreads();
        if (!SAMPLE && item + G < nitem) HO_LOAD(item + G);
        if (!SAMPLE) { const int dv = tid >> 2, kc = (tid & 3) * 32;
#pragma unroll
            for (int q = 0; q < 4; ++q) { const f32x4 s0 = sreg[2 * q], s1 = sreg[2 * q + 1]; const float* e = eR + kc + 8 * q;
                u32x4 o; o.x = pk2(s0.x * e[0], s0.y * e[1]); o.y = pk2(s0.z * e[2], s0.w * e[3]); o.z = pk2(s1.x * e[4], s1.y * e[5]); o.w = pk2(s1.z * e[6], s1.w * e[7]);
                *(u32x4*)(Bcat + dv * 200 + kc + 8 * q) = o; }
        } else {
            const int kk = tid >> 2, dc = (tid & 3) * 32; const float e = eR[kk];
#pragma unroll
            for (int q = 0; q < 8; ++q) { const f32x4 s = sreg[q];
                Bcat[(dc + 4 * q + 0) * 200 + kk] = (bf16)f2bf(s.x * e); Bcat[(dc + 4 * q + 1) * 200 + kk] = (bf16)f2bf(s.y * e);
                Bcat[(dc + 4 * q + 2) * 200 + kk] = (bf16)f2bf(s.z * e); Bcat[(dc + 4 * q + 3) * 200 + kk] = (bf16)f2bf(s.w * e); }
        }
        { const int tt = w >> 1;
#pragma unroll
            for (int sj = 0; sj < 2; ++sj) { const int st = 2 * (w & 1) + sj; f32x4 acc = (f32x4){0.f, 0.f, 0.f, 0.f};
                if (st <= tt) {
#pragma unroll
                    for (int ks = 0; ks < 4; ++ks) acc = MFMA16(ldfrag(Acat, 200, 16 * tt, 32 * ks, lane), ldfrag(Kx, 136, 16 * st, 32 * ks, lane), acc); }
                const int s = 16 * st + (lane & 15);
#pragma unroll
                for (int r = 0; r < 4; ++r) { const int t = 16 * tt + 4 * (lane >> 4) + r; Acat[t * 200 + 128 + s] = (bf16)f2bf(s <= t ? acc[r] : 0.f); } } }
        __syncthreads();
        { const int tt = w & 3, d0 = 4 * (w >> 2); f32x4 acc[4];
#pragma unroll
            for (int j = 0; j < 4; ++j) acc[j] = (f32x4){0.f, 0.f, 0.f, 0.f};
#pragma unroll
            for (int ks = 0; ks < 6; ++ks) { const bf16x8 a = ldfrag(Acat, 200, 16 * tt, 32 * ks, lane);
#pragma unroll
                for (int j = 0; j < 4; ++j) acc[j] = MFMA16(a, ldfrag(Bcat, 200, 16 * (d0 + j), 32 * ks, lane), acc[j]); }
#pragma unroll
            for (int j = 0; j < 4; ++j)
#pragma unroll
                for (int r = 0; r < 4; ++r) osh[(16 * tt + 4 * (lane >> 4) + r) * 132 + 16 * (d0 + j) + (lane & 15)] = acc[j][r]; }
        __syncthreads();
        { const int t = tid >> 3, pc = (tid & 7) * 16; const bool ok = !SAMPLE || t < DEC_S; const int row = SAMPLE ? row_of_sample(n, t & 3) : n * 64 + t;
            float o[16], ss = 0.f;
#pragma unroll
            for (int j = 0; j < 16; ++j) { o[j] = osh[t * 132 + pc + j]; ss += o[j] * o[j]; }
            ss += shx(ss, 1, lane); ss += shx(ss, 2, lane); ss += shx(ss, 4, lane);
            const float rs = rsqrtf(ss * (1.f / 128.f) + EPS);
            if (ok) { const unsigned gw[8] = {zg0.x, zg0.y, zg0.z, zg0.w, zg1.x, zg1.y, zg1.z, zg1.w};
                unsigned ow[8];
#pragma unroll
                for (int j = 0; j < 8; ++j) { const float a0 = o[2 * j] * rs * nwl[h * 128 + pc + 2 * j] * __uint_as_float(gw[j] << 16), a1 = o[2 * j + 1] * rs * nwl[h * 128 + pc + 2 * j + 1] * __uint_as_float(gw[j] & 0xffff0000u); ow[j] = pk2(a0, a1); }
                u32x4* op = (u32x4*)(OA + (size_t)row * 1536 + h * 128 + pc); op[0] = (u32x4){ow[0], ow[1], ow[2], ow[3]}; op[1] = (u32x4){ow[4], ow[5], ow[6], ow[7]}; }
        }
        if (!SAMPLE) cp.commit(KVC_OUT_BASE + item * 512 * KVC_OUT_NPT, tid, kc0, kc1, kc2, outp);
        if (SAMPLE) {
            const int kk = tid >> 2, dc = (tid & 3) * 32; const size_t so = ((size_t)(n * 8 + h) * 128 + kk) * 128 + dc;
            const float dk = expf(tot[kk] + tot[128 + kk] + tot[256 + kk] + tot[384 + kk]);
            const float w0 = wk[kk], w1 = wk[128 + kk], w2 = wk[256 + kk], w3 = wk[384 + kk];
#pragma unroll
            for (int q = 0; q < 8; ++q) { const f32x4 s = sreg[q]; f32x4 o;
#pragma unroll
                for (int e = 0; e < 4; ++e) { const int dv = dc + 4 * q + e; o[e] = dk * s[e] + w0 * vv[dv] + w1 * vv[128 + dv] + w2 * vv[256 + dv] + w3 * vv[384 + dv]; }
                *(f32x4*)(out_hs + so + 4 * q) = o; }
        }
    }
}
#undef HO_LOAD
constexpr int HGRN_OUT_LDS = (64 * 200 + 64 * 136 + 128 * 200) * 2 + (64 * 132 + 512 + 128 + 512 + 512) * 4;

__device__ __forceinline__ float alibi_slope(int g, int h) { return exp2f(-8.f * (float)(g * 4 + h + 1) / 12.f); }
__device__ __forceinline__ void p_attn_prompt(const bf16* __restrict__ Z, bf16* __restrict__ OG, float* __restrict__ LSE, unsigned char* smem, int vcu, int G, int wv) {
    bf16* Ksh = (bf16*)smem;
    bf16* VT = Ksh + 256 * 136;
    const int tid = otid(wv), lane = tid & 63, w = tid >> 6;
    u32x4 pkx[8], pvx[8];
#define AT_LOAD(item_) do { const int gh_ = (item_) >> 7, g_ = gh_ >> 2, h_ = gh_ & 3, wi_ = (item_) & 127, dil_ = g_ == 0 ? 1 : (g_ == 1 ? 4 : 16), nqb_ = 128 / dil_, r_ = wi_ / nqb_, m0_ = (wi_ % nqb_) * 128; \
        const int t_ = otid(wv); const int m_ = m0_ - 128 + (t_ >> 1); const bool ok_ = m_ >= 0; const size_t row_ = ok_ ? (size_t)m_ * dil_ + r_ : 0; \
        const u32x4* kp_ = (const u32x4*)(Z + row_ * NIN + C_AK + g_ * 512 + h_ * 128 + (t_ & 1) * 64); const u32x4* vp_ = (const u32x4*)(Z + row_ * NIN + C_AV + g_ * 512 + h_ * 128 + (t_ & 1) * 64); \
        _Pragma("unroll") for (int j = 0; j < 8; ++j) { pkx[j] = (u32x4){0u, 0u, 0u, 0u}; pvx[j] = pkx[j]; if (ok_) { pkx[j] = kp_[j]; pvx[j] = vp_[j]; } } } while (0)
    if (vcu < 12 * 128) AT_LOAD(vcu);
    for (int item = vcu; item < 12 * 128; item += G) {
        const int gh = item >> 7, g = gh >> 2, h = gh & 3, within = item & 127;
        const int dil = g == 0 ? 1 : (g == 1 ? 4 : 16), nqb = 128 / dil, r = within / nqb, qb = within % nqb, m0 = qb * 128;
        const int i0 = 16 * w, jstart = 32 * (w >> 1);
        const size_t qrow = (size_t)(m0 + i0 + (lane & 15)) * dil + r;
        bf16x8 qf[4];
#pragma unroll
        for (int ks = 0; ks < 4; ++ks) qf[ks] = *(const bf16x8*)(Z + qrow * NIN + C_AQ + g * 512 + h * 128 + 32 * ks + 8 * (lane >> 4));
        __syncthreads();
        {
            const int key = tid >> 1, half = tid & 1;
#pragma unroll
            for (int j = 0; j < 8; ++j) { *(u32x4*)(Ksh + key * 136 + half * 64 + 8 * j) = pkx[j]; const unsigned ww[4] = {pvx[j].x, pvx[j].y, pvx[j].z, pvx[j].w};
#pragma unroll
                for (int e = 0; e < 4; ++e) { const int d = half * 64 + 8 * j + 2 * e; VT[d * 264 + key] = (bf16)(ww[e] & 0xffffu); VT[(d + 1) * 264 + key] = (bf16)(ww[e] >> 16); } }
        }
        if (item + G < 12 * 128) AT_LOAD(item + G);
        __syncthreads();
        f32x4 sacc[10];
#pragma unroll
        for (int jt = 0; jt < 10; ++jt) { sacc[jt] = (f32x4){0.f, 0.f, 0.f, 0.f};
#pragma unroll
            for (int ks = 0; ks < 4; ++ks) sacc[jt] = MFMA16(ldfrag(Ksh, 136, jstart + 16 * jt, 32 * ks, lane), qf[ks], sacc[jt]); }
        const float slope = alibi_slope(g, h) * (float)dil; const int iq = i0 + (lane & 15);
        float mx = -3.0e38f;
#pragma unroll
        for (int jt = 0; jt < 10; ++jt)
#pragma unroll
            for (int rr = 0; rr < 4; ++rr) { const int j = jstart + 16 * jt + 4 * (lane >> 4) + rr, delta = 128 + iq - j; const bool valid = delta >= 0 && delta <= 128 && (m0 - 128 + j) >= 0;
                const float s = valid ? sacc[jt][rr] * 0.08838834764831845f - slope * (float)delta : -3.0e38f; sacc[jt][rr] = s; mx = fmaxf(mx, s); }
        mx = fmaxf(mx, shx(mx, 16, lane)); mx = fmaxf(mx, shx(mx, 32, lane));
        float den = 0.f;
#pragma unroll
        for (int jt = 0; jt < 10; ++jt)
#pragma unroll
            for (int rr = 0; rr < 4; ++rr) { const float p = sacc[jt][rr] > -1.0e38f ? expf(sacc[jt][rr] - mx) : 0.f; sacc[jt][rr] = p; den += p; }
        den += shx(den, 16, lane); den += shx(den, 32, lane);
        f32x4 oacc[8];
#pragma unroll
        for (int dt = 0; dt < 8; ++dt) oacc[dt] = (f32x4){0.f, 0.f, 0.f, 0.f};
#pragma unroll
        for (int ks = 0; ks < 5; ++ks) {
            u32x4 pw; pw.x = pk2(sacc[2 * ks][0], sacc[2 * ks][1]); pw.y = pk2(sacc[2 * ks][2], sacc[2 * ks][3]); pw.z = pk2(sacc[2 * ks + 1][0], sacc[2 * ks + 1][1]); pw.w = pk2(sacc[2 * ks + 1][2], sacc[2 * ks + 1][3]);
            const bf16x8 pf = __builtin_bit_cast(bf16x8, pw);
#pragma unroll
            for (int dt = 0; dt < 8; ++dt) { const bf16* vb = VT + (16 * dt + (lane & 15)) * 264 + jstart + 32 * ks + 4 * (lane >> 4);
                const u32x2 lo = *(const u32x2*)vb, hi = *(const u32x2*)(vb + 16); const u32x4 vw = (u32x4){lo.x, lo.y, hi.x, hi.y};
                oacc[dt] = MFMA16(pf, __builtin_bit_cast(bf16x8, vw), oacc[dt]); } }
        float inv[4];
#pragma unroll
        for (int rr = 0; rr < 4; ++rr) inv[rr] = 1.f / shl(den, 4 * (lane >> 4) + rr);
#pragma unroll
        for (int rr = 0; rr < 4; ++rr) { const size_t orow = (size_t)(m0 + i0 + 4 * (lane >> 4) + rr) * dil + r; bf16* op = OG + ((size_t)g * MPAD + orow) * 512 + h * 128 + (lane & 15);
#pragma unroll
            for (int dt = 0; dt < 8; ++dt) op[16 * dt] = (bf16)f2bf(oacc[dt][rr] * inv[rr]); }
        if (lane < 16) LSE[((size_t)g * MPAD + qrow) * 4 + h] = mx + logf(den);
    }
}
#undef AT_LOAD
constexpr int ATTN_LDS = (256 * 136 + 128 * 264) * 2;

__device__ __forceinline__ void p_attn_sample(const bf16* __restrict__ Z, const float* __restrict__ c0, const float* __restrict__ c1, const float* __restrict__ c2, bf16* __restrict__ OG, float* __restrict__ LSE, int vcu, int G, int wv) {
    const int tid_ = otid(wv), lane = tid_ & 63, gw = (tid_ >> 6) * G + vcu, ngw = G * 8;
    for (int it = gw; it < DEC_B * DEC_S * 12; it += ngw) {
        const int h = it & 3, g = (it >> 2) % 3, bs = it / 12, b = bs >> 2, s = bs & 3;
        const int dil = g == 0 ? 1 : (g == 1 ? 4 : 16), L = 128 * dil; const float* cache = g == 0 ? c0 : (g == 1 ? c1 : c2);
        const int row = row_of_sample(b, s), n_new = dil == 1 ? s + 1 : 1;
        const float slope = alibi_slope(g, h) * (float)dil;
        const unsigned qw = *(const unsigned*)(Z + (size_t)row * NIN + C_AQ + g * 512 + h * 128 + 2 * lane);
        const float q0 = bflo_(qw) * 0.08838834764831845f, q1 = bfhi_(qw) * 0.08838834764831845f;
        const float* kb = cache + (size_t)b * L * 1024 + h * 128 + 2 * lane;
        float s0v = -3.0e38f, s1v = -3.0e38f, s2v = -3.0e38f;
        float2 kk[8], kn[8];
#define AS_LOAD(dst, jb_, off_) do { _Pragma("unroll") for (int q = 0; q < 8; ++q) { int idx = L + s - ((jb_) + q) * dil; idx = idx < L ? idx : L - 1; dst[q] = *(const float2*)(kb + (size_t)idx * 1024 + (off_)); } } while (0)
        AS_LOAD(kk, 0, 0);
        for (int jb = 0; jb < 128; jb += 8) {
            if (jb + 8 < 128) AS_LOAD(kn, jb + 8, 0);
#pragma unroll
            for (int q = 0; q < 8; ++q) { const int j = jb + q; const float d = wave_sum(q0 * kk[q].x + q1 * kk[q].y, lane) - slope * (float)j; if ((j & 63) == lane) { if (jb < 64) s0v = d; else s1v = d; } }
#pragma unroll
            for (int q = 0; q < 8; ++q) kk[q] = kn[q]; }
        { const float2 kv = *(const float2*)(kb + (size_t)(L + s - 128 * dil) * 1024); const float d = wave_sum(q0 * kv.x + q1 * kv.y, lane) - slope * 128.f; if (lane == 0) s2v = d; }
        for (int j = 0; j < n_new; ++j) { const unsigned kw = *(const unsigned*)(Z + (size_t)row_of_sample(b, s - j * dil) * NIN + C_AK + g * 512 + h * 128 + 2 * lane);
            const float d = wave_sum(q0 * bflo_(kw) + q1 * bfhi_(kw), lane) - slope * (float)j; if (lane == j) s0v = d; }
        float mx = fmaxf(fmaxf(s0v, s1v), s2v);
#pragma unroll
        for (int o = 1; o < 64; o <<= 1) mx = fmaxf(mx, shx(mx, o, lane));
        const float p0 = s0v > -1.0e38f ? expf(s0v - mx) : 0.f, p1 = s1v > -1.0e38f ? expf(s1v - mx) : 0.f, p2 = s2v > -1.0e38f ? expf(s2v - mx) : 0.f;
        const float den = wave_sum(p0 + p1 + p2, lane);
        float o0 = 0.f, o1 = 0.f;
        AS_LOAD(kk, 0, 512);
        for (int jb = 0; jb < 128; jb += 8) {
            if (jb + 8 < 128) AS_LOAD(kn, jb + 8, 512);
#pragma unroll
            for (int q = 0; q < 8; ++q) { const int j = jb + q; float pj = shl(jb < 64 ? p0 : p1, j & 63); pj = j >= n_new ? pj : 0.f; o0 += pj * kk[q].x; o1 += pj * kk[q].y; }
#pragma unroll
            for (int q = 0; q < 8; ++q) kk[q] = kn[q]; }
#undef AS_LOAD
        { const float2 kv = *(const float2*)(kb + (size_t)(L + s - 128 * dil) * 1024 + 512); const float pj = shl(p2, 0); o0 += pj * kv.x; o1 += pj * kv.y; }
        for (int j = 0; j < n_new; ++j) { const unsigned vw = *(const unsigned*)(Z + (size_t)row_of_sample(b, s - j * dil) * NIN + C_AV + g * 512 + h * 128 + 2 * lane);
            const float pj = shl(p0, j); o0 += pj * bflo_(vw); o1 += pj * bfhi_(vw); }
        const float inv = 1.f / den;
        *(unsigned*)(OG + ((size_t)g * MPAD + row) * 512 + h * 128 + 2 * lane) = pk2(o0 * inv, o1 * inv);
        if (lane == 0) LSE[((size_t)g * MPAD + row) * 4 + h] = mx + logf(den);
    }
}
__device__ __forceinline__ void p_attn_merge(const bf16* __restrict__ OG, const float* __restrict__ LSE, bf16* __restrict__ OB, int vcu, int G, int wv) {
    const size_t nchunk = (size_t)MROWS * 64, gsz = (size_t)G * 512;
    for (size_t i0 = (size_t)vcu * 512 + otid(wv); i0 < nchunk; i0 += 4 * gsz) {
        float l[4][3]; u32x4 og[4][3];
#pragma unroll
        for (int q = 0; q < 4; ++q) { size_t i = i0 + q * gsz; i = i < nchunk ? i : nchunk - 1; const int row = (int)(i >> 6), c0 = (int)(i & 63) * 8, h = c0 >> 7;
#pragma unroll
            for (int g = 0; g < 3; ++g) { l[q][g] = LSE[((size_t)g * MPAD + row) * 4 + h]; og[q][g] = *(const u32x4*)(OG + ((size_t)g * MPAD + row) * 512 + c0); } }
#pragma unroll
        for (int q = 0; q < 4; ++q) { const size_t i = i0 + q * gsz; if (i >= nchunk) continue; const int row = (int)(i >> 6), c0 = (int)(i & 63) * 8;
            const float l0 = l[q][0], l1 = l[q][1], l2 = l[q][2];
            const float m = fmaxf(l0, fmaxf(l1, l2)); float w0 = expf(l0 - m), w1 = expf(l1 - m), w2 = expf(l2 - m); const float inv = 1.f / (w0 + w1 + w2); w0 *= inv; w1 *= inv; w2 *= inv;
            const u32x4 a = og[q][0], bq = og[q][1], c = og[q][2];
            const unsigned aw[4] = {a.x, a.y, a.z, a.w}, bw[4] = {bq.x, bq.y, bq.z, bq.w}, cw[4] = {c.x, c.y, c.z, c.w}; unsigned ow[4];
#pragma unroll
            for (int e = 0; e < 4; ++e) { const float lo = w0 * __uint_as_float(aw[e] << 16) + w1 * __uint_as_float(bw[e] << 16) + w2 * __uint_as_float(cw[e] << 16);
                const float hi = w0 * __uint_as_float(aw[e] & 0xffff0000u) + w1 * __uint_as_float(bw[e] & 0xffff0000u) + w2 * __uint_as_float(cw[e] & 0xffff0000u); ow[e] = pk2(lo, hi); }
            *(u32x4*)(OB + (size_t)row * 1536 + 1024 + c0) = (u32x4){ow[0], ow[1], ow[2], ow[3]}; }
    }
}
template <int PART  >
__device__ __forceinline__ void p_kv_out(const bf16* __restrict__ Z, const float* __restrict__ c0, const float* __restrict__ c1, const float* __restrict__ c2, float* __restrict__ out, int vcu, int G, int wv) {
    const size_t gtid = (size_t)vcu * 512 + otid(wv), gsz = (size_t)G * 512;
    for (int g = 0; g < 3; ++g) {
        const int dil = g == 0 ? 1 : (g == 1 ? 4 : 16), L = 128 * dil; const float* cache = g == 0 ? c0 : (g == 1 ? c1 : c2);
        float* op = out + (g == 0 ? O_KV0P : (g == 1 ? O_KV1P : O_KV2P)); float* os = out + (g == 0 ? O_KV0S : (g == 1 ? O_KV1S : O_KV2S));
        if (PART == 1) for (size_t i = gtid; i < (size_t)L * 256; i += gsz) { const int j = (int)(i >> 8), c = (int)(i & 255) * 4, kv = c >> 9, hd = c & 511; const int tok = TP - L + j;
            const u32x2 w = *(const u32x2*)(Z + (size_t)tok * NIN + (kv ? C_AV : C_AK) + g * 512 + hd);
            *(f32x4*)(op + (size_t)j * 1024 + c) = (f32x4){__uint_as_float(w.x << 16), __uint_as_float(w.x & 0xffff0000u), __uint_as_float(w.y << 16), __uint_as_float(w.y & 0xffff0000u)}; }
        if (PART == 1) for (size_t i = gtid; i < (size_t)NSMP * 256; i += gsz) { const int bs = (int)(i >> 8), b = bs >> 2, s = bs & 3, c = (int)(i & 255) * 4, kv = c >> 9, hd = c & 511;
            const u32x2 w = *(const u32x2*)(Z + (size_t)row_of_sample(b, s) * NIN + (kv ? C_AV : C_AK) + g * 512 + hd);
            *(f32x4*)(os + ((size_t)b * L + (L - DEC_S + s)) * 1024 + c) = (f32x4){__uint_as_float(w.x << 16), __uint_as_float(w.x & 0xffff0000u), __uint_as_float(w.y << 16), __uint_as_float(w.y & 0xffff0000u)}; }
        if (PART == 0) { const size_t per_b = (size_t)(L - DEC_S) * 256, ntot = (size_t)DEC_B * per_b;
            for (size_t i0 = gtid; i0 < ntot; i0 += 16 * gsz) { f32x4 v[16];
#pragma unroll
                for (int q = 0; q < 16; ++q) { const size_t i = i0 + q * gsz; if (i < ntot) { const size_t bb = i / per_b, e = i - bb * per_b; v[q] = __builtin_nontemporal_load((const f32x4*)(cache + bb * L * 1024 + (size_t)DEC_S * 1024) + e); } }
#pragma unroll
                for (int q = 0; q < 16; ++q) { const size_t i = i0 + q * gsz; if (i < ntot) { const size_t bb = i / per_b, e = i - bb * per_b; __builtin_nontemporal_store(v[q], (f32x4*)(os + bb * L * 1024) + e); } } } }
    }
}
__device__ __forceinline__ void kvn_addr(int i, const bf16* Z, float* out, const u32x2*& src, f32x4*& dst) {
    constexpr int P0 = 128 * 256, P1 = P0 + 512 * 256, P2 = P1 + 2048 * 256, SN = NSMP * 256;
    int g, j; bool smp = false;
    if (i < P0) { g = 0; j = i; } else if (i < P1) { g = 1; j = i - P0; } else if (i < P2) { g = 2; j = i - P1; } else { smp = true; const int r = i - P2; g = r / SN; j = r - g * SN; }
    const int L = g == 0 ? 128 : (g == 1 ? 512 : 2048), c = (j & 255) * 4, kv = c >> 9, hd = c & 511, rw = j >> 8;
    if (!smp) { src = (const u32x2*)(Z + (size_t)(TP - L + rw) * NIN + (kv ? C_AV : C_AK) + g * 512 + hd); dst = (f32x4*)(out + (g == 0 ? O_KV0P : (g == 1 ? O_KV1P : O_KV2P)) + (size_t)rw * 1024 + c); }
    else { const int b_ = rw >> 2, s_ = rw & 3; src = (const u32x2*)(Z + (size_t)row_of_sample(b_, s_) * NIN + (kv ? C_AV : C_AK) + g * 512 + hd);
           dst = (f32x4*)(out + (g == 0 ? O_KV0S : (g == 1 ? O_KV1S : O_KV2S)) + ((size_t)b_ * L + (L - DEC_S + s_)) * 1024 + c); }
}
__device__ __forceinline__ void p_kv_new(const bf16* __restrict__ Z, float* __restrict__ out, int vcu, int G, int wv) {
    constexpr int NTOT = (128 + 512 + 2048) * 256 + 3 * NSMP * 256;
    const int gtid = vcu * 512 + otid(wv), gsz = G * 512;
    for (int i0 = gtid; i0 < NTOT; i0 += 6 * gsz) { u32x2 w[6];
#pragma unroll
        for (int q = 0; q < 6; ++q) { int i = i0 + q * gsz; i = i < NTOT ? i : NTOT - 1; const u32x2* s_; f32x4* d_; kvn_addr(i, Z, out, s_, d_); w[q] = *s_; }
#pragma unroll
        for (int q = 0; q < 6; ++q) { int i = i0 + q * gsz; i = i < NTOT ? i : NTOT - 1; const u32x2* s_; f32x4* d_; kvn_addr(i, Z, out, s_, d_);
            *d_ = (f32x4){__uint_as_float(w[q].x << 16), __uint_as_float(w[q].x & 0xffff0000u), __uint_as_float(w[q].y << 16), __uint_as_float(w[q].y & 0xffff0000u)}; } }
}
__device__ __forceinline__ void p_mix(const bf16* __restrict__ Z, const bf16* __restrict__ Y1, const bf16* __restrict__ Y2, bf16* __restrict__ MIX, int vcu, int G, int wv) {
    const size_t nchunk = (size_t)MROWS * 256;
    for (size_t i = (size_t)vcu * 512 + otid(wv); i < nchunk; i += (size_t)G * 512) {
        const int row = (int)(i >> 8), c0 = (int)(i & 255) * 8;
        const u32x4 ga = *(const u32x4*)(Z + (size_t)row * NIN + C_GA + c0), gb = *(const u32x4*)(Z + (size_t)row * NIN + C_GB + c0), y1 = *(const u32x4*)(Y1 + (size_t)row * DM + c0), y2 = *(const u32x4*)(Y2 + (size_t)row * DM + c0);
        const unsigned a[4] = {ga.x, ga.y, ga.z, ga.w}, bq[4] = {gb.x, gb.y, gb.z, gb.w}, c[4] = {y1.x, y1.y, y1.z, y1.w}, d[4] = {y2.x, y2.y, y2.z, y2.w}; unsigned ow[4];
#pragma unroll
        for (int e = 0; e < 4; ++e) { const float lo = __uint_as_float(a[e] << 16) * __uint_as_float(c[e] << 16) + __uint_as_float(bq[e] << 16) * __uint_as_float(d[e] << 16);
            const float hi = __uint_as_float(a[e] & 0xffff0000u) * __uint_as_float(c[e] & 0xffff0000u) + __uint_as_float(bq[e] & 0xffff0000u) * __uint_as_float(d[e] & 0xffff0000u); ow[e] = pk2(lo, hi); }
        *(u32x4*)(MIX + (size_t)row * DM + c0) = (u32x4){ow[0], ow[1], ow[2], ow[3]};
    }
}
__device__ __forceinline__ float* yrow(float* out, int row) { return row < TP ? out + O_Y + (size_t)row * DM : out + O_YS + (size_t)(row - TP) * DM; }
__device__ __forceinline__ void p_resid1(const float* __restrict__ xp, const float* __restrict__ xs, const float* __restrict__ C, float* __restrict__ out, bf16* __restrict__ xb, float* __restrict__ r2, int vcu, int G, int wv) {
    const int tid_ = otid(wv), lane = tid_ & 63, gw = vcu * 8 + (tid_ >> 6), ngw = G * 8;
    for (int row = gw; row < MROWS; row += ngw) {
        const f32x4* src = (const f32x4*)(row < TP ? xp + (size_t)row * DM : xs + (size_t)(row - TP) * DM) + lane; const f32x4* cp = (const f32x4*)(C + (size_t)row * DM) + lane;
        f32x4* op = (f32x4*)yrow(out, row) + lane; u32x2* o = (u32x2*)(xb + (size_t)row * DM) + lane; float ss = 0.f;
#pragma unroll
        for (int j = 0; j < 8; ++j) { const f32x4 v = src[64 * j] + cp[64 * j]; ss += v.x * v.x + v.y * v.y + v.z * v.z + v.w * v.w; op[64 * j] = v; o[64 * j] = (u32x2){pk2(v.x, v.y), pk2(v.z, v.w)}; }
        ss = wave_sum(ss, lane); if (lane == 0) r2[row] = rsqrtf(ss * (1.f / DM) + EPS);
    }
}
__device__ __forceinline__ void p_conv(const bf16* __restrict__ U, const float* __restrict__ r2, const float* __restrict__ cbuf, const float* __restrict__ cw, const float* __restrict__ cb, bf16* __restrict__ ACT, float* __restrict__ out, int vcu, int G, int wv) {
    const size_t nchunk = (size_t)MROWS * (DFF / 4);
    for (size_t i = (size_t)vcu * 512 + otid(wv); i < nchunk; i += (size_t)G * 512) {
        const int row = (int)(i / (DFF / 4)), c0 = (int)(i % (DFF / 4)) * 4; const bool smp = row >= TP; const int b = (row - TP) >> 2, s = (row - TP) & 3;
        float res[2][4];
#pragma unroll
        for (int half = 0; half < 2; ++half) { const int col = c0 + half * DFF; float u0[4], u1[4], u2[4];
            { const u32x2 w = *(const u32x2*)(U + (size_t)row * NUP + col); const float r = r2[row]; u2[0] = r * __uint_as_float(w.x << 16); u2[1] = r * __uint_as_float(w.x & 0xffff0000u); u2[2] = r * __uint_as_float(w.y << 16); u2[3] = r * __uint_as_float(w.y & 0xffff0000u); }
            const bool has1 = smp ? (s >= 1) : (row >= 1), has2 = smp ? (s >= 2) : (row >= 2);
            if (has1) { const u32x2 w = *(const u32x2*)(U + (size_t)(row - 1) * NUP + col); const float r = r2[row - 1]; u1[0] = r * __uint_as_float(w.x << 16); u1[1] = r * __uint_as_float(w.x & 0xffff0000u); u1[2] = r * __uint_as_float(w.y << 16); u1[3] = r * __uint_as_float(w.y & 0xffff0000u); }
            else if (smp) { const f32x4 v = *(const f32x4*)(cbuf + ((size_t)b * 2 + 1) * NUP + col); u1[0] = v.x; u1[1] = v.y; u1[2] = v.z; u1[3] = v.w; }
            else { u1[0] = u1[1] = u1[2] = u1[3] = 0.f; }
            if (has2) { const u32x2 w = *(const u32x2*)(U + (size_t)(row - 2) * NUP + col); const float r = r2[row - 2]; u0[0] = r * __uint_as_float(w.x << 16); u0[1] = r * __uint_as_float(w.x & 0xffff0000u); u0[2] = r * __uint_as_float(w.y << 16); u0[3] = r * __uint_as_float(w.y & 0xffff0000u); }
            else if (smp) { const f32x4 v = *(const f32x4*)(cbuf + ((size_t)b * 2 + s) * NUP + col); u0[0] = v.x; u0[1] = v.y; u0[2] = v.z; u0[3] = v.w; }
            else { u0[0] = u0[1] = u0[2] = u0[3] = 0.f; }
            const f32x4 w0 = *(const f32x4*)(cw + col), w1 = *(const f32x4*)(cw + NUP + col), w2 = *(const f32x4*)(cw + 2 * NUP + col), bb = *(const f32x4*)(cb + col);
#pragma unroll
            for (int e = 0; e < 4; ++e) res[half][e] = bb[e] + w0[e] * u0[e] + w1[e] * u1[e] + w2[e] * u2[e];
            if (!smp && row >= TP - 2) *(f32x4*)(out + O_CVP + (size_t)(row - (TP - 2)) * NUP + col) = (f32x4){u2[0], u2[1], u2[2], u2[3]};
            if (smp && s >= 2) *(f32x4*)(out + O_CVS + ((size_t)b * 2 + (s - 2)) * NUP + col) = (f32x4){u2[0], u2[1], u2[2], u2[3]};
        }
        float a[4];
#pragma unroll
        for (int e = 0; e < 4; ++e) a[e] = res[0][e] * sigmoidf_(res[0][e]) * res[1][e];
        *(u32x2*)(ACT + (size_t)row * DFF + c0) = (u32x2){pk2(a[0], a[1]), pk2(a[2], a[3])};
    }
}
__device__ __forceinline__ void p_final(const float* __restrict__ C, const float* __restrict__ wf, float* __restrict__ out, int vcu, int G, int wv) {
    const int tid_ = otid(wv), lane = tid_ & 63, gw = vcu * 8 + (tid_ >> 6), ngw = G * 8;
    for (int row = gw; row < MROWS; row += ngw) {
        const f32x4* cp = (const f32x4*)(C + (size_t)row * DM) + lane; f32x4* op = (f32x4*)yrow(out, row) + lane; const f32x4* wp = (const f32x4*)wf + lane;
        f32x4 v[8]; float ss = 0.f;
#pragma unroll
        for (int j = 0; j < 8; ++j) { v[j] = op[64 * j] + cp[64 * j]; ss += v[j].x * v[j].x + v[j].y * v[j].y + v[j].z * v[j].z + v[j].w * v[j].w; }
        ss = wave_sum(ss, lane); const float rs = rsqrtf(ss * (1.f / DM) + EPS);
#pragma unroll
        for (int j = 0; j < 8; ++j) op[64 * j] = v[j] * rs * wp[64 * j];
    }
}


__device__ __forceinline__ void p_r2(const float* __restrict__ SSP, float* __restrict__ r2, int vcu, int G, int wv) {
    for (int row = vcu * 512 + otid(wv); row < MPAD; row += G * 512) { const f32x4* p = (const f32x4*)(SSP + (size_t)row * 32); float ss = 0.f;
#pragma unroll
        for (int j = 0; j < 8; ++j) { const f32x4 v = p[j]; ss += (v.x + v.y) + (v.z + v.w); }
        r2[row] = row < MROWS ? rsqrtf(ss * (1.f / DM) + EPS) : 1.f; }
}
__device__ __forceinline__ void p_final2(const float* __restrict__ SSP, const float* __restrict__ wf, float* __restrict__ out, int vcu, int G, int wv) {
    const int tid_ = otid(wv), lane = tid_ & 63, gw = vcu * 8 + (tid_ >> 6), ngw = G * 8;
    for (int row = gw; row < MROWS; row += ngw) {
        f32x4* op = (f32x4*)yrow(out, row) + lane; const f32x4* wp = (const f32x4*)wf + lane;
        const float ss = wave_sum(lane < 32 ? SSP[(size_t)row * 32 + lane] : 0.f, lane); const float rs = rsqrtf(ss * (1.f / DM) + EPS);
#pragma unroll
        for (int j = 0; j < 8; ++j) op[64 * j] = op[64 * j] * rs * wp[64 * j];
    }
}

__device__ __forceinline__ void p_reduce_out(const float* __restrict__ xs, const float* __restrict__ slab, int KS, float* __restrict__ out, bf16* __restrict__ xb, const float* __restrict__ SSP, float* __restrict__ R2, int vcu, int G, int wv) {
    const int tid_ = otid(wv), lane = tid_ & 63, gw = vcu * 8 + (tid_ >> 6), ngw = G * 8;
    for (int r = gw; r < NSMP; r += ngw) { const int row = TP + r;
        const f32x4* src = (const f32x4*)(xs + (size_t)r * DM) + lane; f32x4* op = (f32x4*)(out + O_YS + (size_t)r * DM) + lane; u32x2* o = (u32x2*)(xb + (size_t)row * DM) + lane; float ss = 0.f;
#pragma unroll
        for (int j = 0; j < 8; ++j) { f32x4 v = src[64 * j];
            for (int ks = 0; ks < KS; ++ks) v += ((const f32x4*)(slab + ((size_t)ks * 128 + r) * DM) + lane)[64 * j];
            ss += v.x * v.x + v.y * v.y + v.z * v.z + v.w * v.w; op[64 * j] = v; o[64 * j] = (u32x2){pk2(v.x, v.y), pk2(v.z, v.w)}; }
        ss = wave_sum(ss, lane);
        if (lane == 0) R2[row] = rsqrtf(ss * (1.f / DM) + EPS);
    }
    for (int row = gw; row < TP; row += ngw) {
        const float ss = wave_sum(lane < 32 ? SSP[(size_t)row * 32 + lane] : 0.f, lane); if (lane == 0) R2[row] = rsqrtf(ss * (1.f / DM) + EPS); }
}
__device__ __forceinline__ void p_final3(const float* __restrict__ SSP, const float* __restrict__ slab, int KS, const float* __restrict__ wf, float* __restrict__ out, int vcu, int G, int wv) {
    const int tid_ = otid(wv), lane = tid_ & 63, gw = vcu * 8 + (tid_ >> 6), ngw = G * 8;
    for (int row = gw; row < MROWS; row += ngw) {
        f32x4* op = (f32x4*)yrow(out, row) + lane; const f32x4* wp = (const f32x4*)wf + lane;
        if (row < TP) {
            const float ss = wave_sum(lane < 32 ? SSP[(size_t)row * 32 + lane] : 0.f, lane); const float rs = rsqrtf(ss * (1.f / DM) + EPS);
#pragma unroll
            for (int j = 0; j < 8; ++j) op[64 * j] = op[64 * j] * rs * wp[64 * j];
        } else { const int r = row - TP; f32x4 v[8]; float ss = 0.f;
#pragma unroll
            for (int j = 0; j < 8; ++j) { v[j] = op[64 * j];
                for (int ks = 0; ks < KS; ++ks) v[j] += ((const f32x4*)(slab + ((size_t)ks * 128 + r) * DM) + lane)[64 * j];
                ss += v[j].x * v[j].x + v[j].y * v[j].y + v[j].z * v[j].z + v[j].w * v[j].w; }
            ss = wave_sum(ss, lane); const float rs = rsqrtf(ss * (1.f / DM) + EPS);
#pragma unroll
            for (int j = 0; j < 8; ++j) op[64 * j] = v[j] * rs * wp[64 * j];
        }
    }
}

struct WDesc { const float* W; bf16* WT; const float* ks; int N, ldo, remap, k0, n0; bool live; };
__device__ __forceinline__ WDesc wdecode(int t, const float* w_in, const float* wpa, const float* wpb, const float* wout, const float* wup, const float* wdn, const float* nmw, const float* nfw,
                                         bf16* WinT, bf16* WpT, bf16* WoutT, bf16* WupT, bf16* WdnT, bf16* DUMP) {
    WDesc d; d.live = true; d.remap = 0; d.ks = nullptr; int nbn;
    if (t < 1600) { d.W = w_in; d.WT = WinT; d.ks = nmw; d.N = NIN; d.ldo = DM; nbn = 50; }
    else if ((t -= 1600) < 1408) { d.W = wup; d.WT = WupT; d.ks = nfw; d.N = NUP; d.ldo = DM; d.remap = 1; nbn = 44; }
    else if ((t -= 1408) < 704) { d.W = wdn; d.WT = WdnT; d.N = DM; d.ldo = DFF; nbn = 8; }
    else if ((t -= 704) < 256) { d.W = wout; d.WT = WoutT; d.N = DM; d.ldo = DM; nbn = 8; }
    else if ((t -= 256) < 128) { d.W = wpa; d.WT = WpT; d.N = DM; d.ldo = 1536; nbn = 8; }
    else if ((t -= 128) < 64) { d.W = wpb; d.WT = WpT + 1024; d.N = DM; d.ldo = 1536; nbn = 8; }
    else { d.W = w_in; d.WT = DUMP; d.N = NIN; d.ldo = DM; nbn = 50; t = 0; d.live = false; }
    d.k0 = (t / nbn) * 64; d.n0 = (t % nbn) * 256; return d;
}
__device__ __forceinline__ void p_wtrans_all(const float* w_in, const float* wpa, const float* wpb, const float* wout, const float* wup, const float* wdn, const float* nmw, const float* nfw,
                                             bf16* WinT, bf16* WpT, bf16* WoutT, bf16* WupT, bf16* WdnT, bf16* DUMP, unsigned char* lds, int vcu, int G, int wv) {
    const int tid = otid(wv), lane = tid & 63, w = tid >> 6;
    float* tile = (float*)lds;
    constexpr int NT = 1600 + 1408 + 704 + 256 + 128 + 64;
    const int niter = (NT + G - 1) / G;
    f32x4 b0[8], b1[8], b2[8]; float s0[8], s1[8], s2[8]; bool h0, h1, h2;
#define WT_LOAD(dst, sc, hs, it) do { const WDesc d = wdecode((it) * G + vcu, w_in, wpa, wpb, wout, wup, wdn, nmw, nfw, WinT, WpT, WoutT, WupT, WdnT, DUMP); \
        _Pragma("unroll") for (int i = 0; i < 8; ++i) { const int kk = 8 * i + w; dst[i] = *(const f32x4*)(d.W + (size_t)(d.k0 + kk) * d.N + d.n0 + 4 * lane); } \
        hs = d.ks != nullptr; const float* kp = hs ? d.ks + d.k0 : nmw; _Pragma("unroll") for (int i = 0; i < 8; ++i) sc[i] = kp[8 * i + w]; } while (0)
#define WT_STEP(cur, cs, hc, nxt, ns, hn, it) do { \
        _Pragma("unroll") for (int i = 0; i < 8; ++i) { float* tp = tile + (8 * i + w) * 257 + 4 * lane; const float m_ = hc ? cs[i] : 1.f; tp[0] = cur[i][0] * m_; tp[1] = cur[i][1] * m_; tp[2] = cur[i][2] * m_; tp[3] = cur[i][3] * m_; } \
        __syncthreads(); \
        WT_LOAD(nxt, ns, hn, (it) + 2); \
        { const WDesc d = wdecode((it) * G + vcu, w_in, wpa, wpb, wout, wup, wdn, nmw, nfw, WinT, WpT, WoutT, WupT, WdnT, DUMP); \
            _Pragma("unroll") for (int r = 0; r < 4; ++r) { const int q = tid + 512 * r, n = q >> 3, c = q & 7; const float* tp = tile + (8 * c) * 257 + n; \
                u32x4 o; o.x = pk2(tp[0], tp[257]); o.y = pk2(tp[2 * 257], tp[3 * 257]); o.z = pk2(tp[4 * 257], tp[5 * 257]); o.w = pk2(tp[6 * 257], tp[7 * 257]); \
                int nn = d.n0 + n; if (d.remap) nn = nn < DFF ? (nn >> 7) * 256 + (nn & 127) : ((nn - DFF) >> 7) * 256 + 128 + ((nn - DFF) & 127); \
                *(u32x4*)(d.WT + (size_t)nn * d.ldo + d.k0 + 8 * c) = o; } } \
        __syncthreads(); } while (0)
    WT_LOAD(b0, s0, h0, 0); WT_LOAD(b1, s1, h1, 1);
    int it = 0;
    for (; it + 2 < niter; it += 3) {
        WT_STEP(b0, s0, h0, b2, s2, h2, it);
        WT_STEP(b1, s1, h1, b0, s0, h0, it + 1);
        WT_STEP(b2, s2, h2, b1, s1, h1, it + 2);
    }
    if (it < niter) { WT_STEP(b0, s0, h0, b2, s2, h2, it); if (it + 1 < niter) WT_STEP(b1, s1, h1, b0, s0, h0, it + 1); }
#undef WT_STEP
#undef WT_LOAD
}

constexpr int LDS_BYTES = 147456;
constexpr int MISC_OFF = LDS_BYTES - 512;
constexpr size_t WS_CTL = 0, CTL_ZERO_BYTES = 65536;
struct Args { const float* in[20]; float* out; unsigned char* ws; };
__device__ __forceinline__ const float* ld_ptr(LAS unsigned char* p) { const unsigned lo = __builtin_amdgcn_readfirstlane(((LAS unsigned*)p)[0]), hi = __builtin_amdgcn_readfirstlane(((LAS unsigned*)p)[1]);
    return (const float*)(const __attribute__((address_space(1))) float*)(((unsigned long long)hi << 32) | lo); }

__global__ void __launch_bounds__(512, 2) mega_fwd(Args a) {
    extern __shared__ __attribute__((aligned(16))) unsigned char lds[];
    cg::grid_group grid = cg::this_grid();
    const int wv = __builtin_amdgcn_readfirstlane((int)threadIdx.x >> 6), tid = otid(wv), G = (int)gridDim.x, vcu = (int)blockIdx.x;
    float* out = a.out; unsigned char* ws = a.ws;
    bf16* WinT = (bf16*)(ws + WS_WIN); bf16* WpaT = (bf16*)(ws + WS_WPA); bf16* WpbT = (bf16*)(ws + WS_WPB); bf16* WoutT = (bf16*)(ws + WS_WOUT); bf16* WupT = (bf16*)(ws + WS_WUP); bf16* WdnT = (bf16*)(ws + WS_WDN);
    bf16* XB = (bf16*)(ws + WS_XB); float* R1 = (float*)(ws + WS_R1); float* R2 = (float*)(ws + WS_R2); float* LBV = (float*)(ws + WS_LB); bf16* Z = (bf16*)(ws + WS_Z); float* G32 = (float*)(ws + WS_G32);
    float* HST = (float*)(ws + WS_HST); float* HD = (float*)(ws + WS_HD); bf16* OA = (bf16*)(ws + WS_OA); bf16* OB = (bf16*)(ws + WS_OB); bf16* OG = (bf16*)(ws + WS_OG); float* LSE = (float*)(ws + WS_LSE);
    bf16* Y1 = (bf16*)(ws + WS_Y1); bf16* Y2 = (bf16*)(ws + WS_Y2); bf16* MIX = (bf16*)(ws + WS_MIX); float* CC = (float*)(ws + WS_C); bf16* UU = (bf16*)(ws + WS_U); bf16* ACT = (bf16*)(ws + WS_ACT); float* SSP1 = (float*)(ws + WS_SSP1); float* SSP2 = (float*)(ws + WS_SSP2); float* SLAB = (float*)(ws + WS_SLAB);

    for (int u = tid; u < 16; u += 512) ((LAS unsigned*)((LAS unsigned char*)lds + MISC_OFF))[u] = 0u;
    if (tid == 0) {
        LAS unsigned long long* pt = (LAS unsigned long long*)((LAS unsigned char*)lds + MISC_OFF + 64);
#pragma unroll
        for (int i = 0; i < 20; ++i) pt[i] = (unsigned long long)a.in[i];
    }
    __syncthreads();
#define INP(i) ld_ptr((LAS unsigned char*)lds + MISC_OFF + 64 + 8 * (i))
    if (vcu == 0) for (int u = tid; u < XCD_BAR_WORDS; u += 512) ((unsigned*)(ws + WS_CTL))[u] = 0u;
#define GRID_BAR() xcd_barrier(bar)
#define GEMM(EPI, g, E) do { pg8::StaticOrder S_; S_.init((g).M, (g).N, G, vcu); pg8::gemm_phase<EPI, pg8::StaticOrder, true, true>((PG8_LAS unsigned char*)lds, (g), S_, (E), wv); } while (0)
#define GEMM_T(EPI, g, E, KS) do { pg8::TailOrder S_; S_.init((g).M, (g).N, (g).K, (KS), G, vcu); pg8::gemm_phase<EPI, pg8::TailOrder, true, true>((PG8_LAS unsigned char*)lds, (g), S_, (E), wv); } while (0)

    { const float* nmw = INP(7); const float* w_in = INP(8); const float* lbl = INP(9); const float* wpa = INP(11); const float* wpb = INP(12); const float* wout = INP(13); const float* nfw = INP(14);
      const float* wup = INP(15); const float* wdn = INP(18); const float* x_p = INP(0); const float* x_s = INP(1); const float* ck0 = INP(3); const float* ck1 = INP(4); const float* ck2 = INP(5);
    p_wtrans_all(w_in, wpa, wpb, wout, wup, wdn, nmw, nfw, WinT, WpaT, WoutT, WupT, WdnT, ACT, lds, vcu, G, wv);
    p_xprep(x_p, x_s, XB, R1, vcu, G, wv);
    p_lb(lbl, LBV, vcu, G, wv);
    }
    __syncthreads();
    grid.sync();
    XcdBarrier bar = xcd_barrier_post((unsigned*)(ws + WS_CTL), (volatile LAS unsigned*)((LAS unsigned char*)lds + MISC_OFF) + 8);
    { pg8::Gemm g{XB, WinT, MPAD, NIN, DM, 256}; pg8::EpiInProj E{Z, G32, R1, LBV, (pg8::u32x4*)(ws + WS_Y1)}; GEMM_T(pg8::EpiInProj, g, E, 1); }
    GRID_BAR();
    { const float* ck0 = INP(3); const float* ck1 = INP(4); const float* ck2 = INP(5); const float* st_h = INP(2); const float* hnw = INP(10);
    p_kv_new(Z, out, vcu, G, wv);
    p_hgrn_local(Z, G32, (bf16*)HST, HD, ck0, ck1, ck2, out, lds, vcu, G, wv);
    p_attn_prompt(Z, OG, LSE, lds, vcu, G, wv);
    p_attn_sample(Z, ck0, ck1, ck2, OG, LSE, vcu, G, wv);
    p_hgrn_out<true>(Z, G32, nullptr, st_h, hnw, OA, out + O_HS, nullptr, nullptr, nullptr, nullptr, lds, vcu, G, wv); }
    GRID_BAR();
    p_hgrn_scan((bf16*)HST, HD, out + O_HP, vcu, G, wv);
    GRID_BAR();
    { const float* hnw = INP(10); p_hgrn_out<false>(Z, G32, (const bf16*)HST, nullptr, hnw, OA, nullptr, INP(3), INP(4), INP(5), out, lds, vcu, G, wv); }
    p_attn_merge(OG, LSE, OA, vcu, G, wv);
    GRID_BAR();
    { pg8::Gemm g{OA, WpaT, MPAD, DM, 1536, 256}; pg8::EpiMixCat E{(const pg8::u32x4*)(ws + WS_Y1), MIX}; GEMM_T(pg8::EpiMixCat, g, E, 1); }
    GRID_BAR();
    { pg8::Gemm g{MIX, WoutT, MPAD, DM, DM, 256}; pg8::EpiResid<true> E{INP(0), INP(1), out, XB, SSP1, SLAB, (pg8::f32x4*)CC}; GEMM_T(pg8::EpiResid<true>, g, E, 8); }
    GRID_BAR();
    { p_reduce_out(INP(1), SLAB, 8, out, XB, SSP1, R2, vcu, G, wv); }
    GRID_BAR();
    { pg8::Gemm g{XB, WupT, MPAD, NUP, DM, 254}; pg8::EpiConv E{ACT, R2, INP(6), INP(16), INP(17), out, (PG8_LAS unsigned char*)lds + 131072}; { pg8::TailHalves S_; S_.init(g.M, g.N, G, vcu); pg8::gemm_phase<pg8::EpiConv, pg8::TailHalves, true, true>((PG8_LAS unsigned char*)lds, g, S_, E, wv); } }
    GRID_BAR();
    { pg8::Gemm g{ACT, WdnT, MPAD, DM, DFF, 256}; pg8::EpiResid<false> E{out, out + O_YS, out, XB, SSP2, SLAB, (pg8::f32x4*)CC}; GEMM_T(pg8::EpiResid<false>, g, E, 11); }
    GRID_BAR();
    p_final3(SSP2, SLAB, 11, INP(19), out, vcu, G, wv);
}

extern "C" void kernel_launch(void* const* d_in, const int* in_sizes, int n_in, void* d_out, int out_size, void* d_ws, size_t ws_size, hipStream_t stream) {
    static int grid = 0;
    if (grid == 0) {
        if (n_in != 20 || (size_t)out_size != O_END || ws_size < WS_END) { fprintf(stderr, "kernel_launch: unexpected shapes (n_in %d out %d ws %zu need %zu)\n", n_in, out_size, ws_size, (size_t)WS_END); grid = -1; return; }
        int dev = 0, cus = 0, per_cu = 0;
        if (hipGetDevice(&dev) != hipSuccess || hipDeviceGetAttribute(&cus, hipDeviceAttributeMultiprocessorCount, dev) != hipSuccess) { grid = -1; return; }
        if (hipFuncSetAttribute((const void*)mega_fwd, hipFuncAttributeMaxDynamicSharedMemorySize, LDS_BYTES) != hipSuccess) { fprintf(stderr, "kernel_launch: hipFuncSetAttribute failed\n"); grid = -1; return; }
        if (hipOccupancyMaxActiveBlocksPerMultiprocessor(&per_cu, (const void*)mega_fwd, 512, LDS_BYTES) != hipSuccess || per_cu < 1) { fprintf(stderr, "kernel_launch: occupancy query says %d\n", per_cu); per_cu = 1; }
        (void)hipGetLastError();
        grid = cus;
    }
    if (grid < 0) return;
    Args a{};
    for (int i = 0; i < 20; ++i) a.in[i] = (const float*)d_in[i];
    a.out = (float*)d_out; a.ws = (unsigned char*)d_ws;
    void* args[] = {&a};
    hipError_t e = hipLaunchCooperativeKernel((const void*)mega_fwd, dim3(grid), dim3(512), args, LDS_BYTES, stream);
    if (e != hipSuccess) fprintf(stderr, "kernel_launch: cooperative launch failed: %s (grid %d)\n", hipGetErrorString(e), grid);
}
```
